# Optimizing an MI355X kernel written in HIP

```python
import jax
import jax.numpy as jnp
from jax import lax
import numpy as np

D_MODEL = 1024
BATCH = 32
SEQ = 256
DEPTH = 4
DEC_BATCH = 8
DEC_SEQ = 4096
PAST_LEN = 256

MIX_W = D_MODEL
ATTN_W = MIX_W // 4
POOL_W = MIX_W // 4
CONV_W = MIX_W // 4
GM_W = MIX_W - ATTN_W - POOL_W - CONV_W
HEAD_DIM = 64
N_Q_HEADS = ATTN_W // HEAD_DIM
N_KV_HEADS = N_Q_HEADS // 2
Q_PER_KV = N_Q_HEADS // N_KV_HEADS
KV_W = N_KV_HEADS * HEAD_DIM
WINDOW = 128
ATTN_BLOCK = 128
GRID_W = 64
ROPE_BASE = 10000.0
ROPE_PAIRS = HEAD_DIM // 4
POOL_GROUPS = 4
POOL_GROUP_W = POOL_W // POOL_GROUPS
POOL_SIZES = (2, 4, 8, 16)
CONV_WIDTH = 31
GM_GROUPS = 4
GM_GROUP_W = GM_W // GM_GROUPS
GM_CHUNK = 128
D_FF = 4 * D_MODEL
N_MOD = 6
EPS = 1e-6
NEG_INF = -1e30
IN_SPLITS = (ATTN_W, ATTN_W + KV_W, ATTN_W + 2 * KV_W, ATTN_W + 2 * KV_W + POOL_W,
             ATTN_W + 2 * KV_W + POOL_W + 2 * CONV_W)
IN_W = IN_SPLITS[-1] + 2 * GM_W

kernel_name = 'hybrid_diffusion_parallel_heads_step'


def _rmsnorm(x, g):
    xf = x.astype(jnp.float32)
    y = xf * lax.rsqrt(jnp.mean(jnp.square(xf), axis=-1, keepdims=True) + EPS)
    return (y * g.astype(jnp.float32)).astype(x.dtype)


def _axial_rope_tables(rows):
    row = jnp.repeat(jnp.arange(rows), GRID_W).astype(jnp.float32)
    col = jnp.tile(jnp.arange(GRID_W), rows).astype(jnp.float32)
    inv = ROPE_BASE ** (-jnp.arange(ROPE_PAIRS, dtype=jnp.float32) / ROPE_PAIRS)
    ang = jnp.concatenate([row[:, None] * inv, col[:, None] * inv], axis=-1)
    return jnp.cos(ang), jnp.sin(ang)


def _apply_rope(x, cos, sin):
    xf = x.astype(jnp.float32)
    x1, x2 = xf[..., :HEAD_DIM // 2], xf[..., HEAD_DIM // 2:]
    cos = cos[None, :, None, :]
    sin = sin[None, :, None, :]
    return jnp.concatenate([x1 * cos - x2 * sin, x1 * sin + x2 * cos], axis=-1).astype(x.dtype)


def _softmax_with_sink(s, sink):
    sk = jnp.broadcast_to(sink.astype(jnp.float32).reshape(N_KV_HEADS, Q_PER_KV, 1, 1), s.shape[:-1] + (1,))
    p = jax.nn.softmax(jnp.concatenate([s, sk], axis=-1), axis=-1)
    return p[..., :-1]


def _context_attention(q, k, v, sink):
    b, n, _, _ = q.shape
    nb = n // ATTN_BLOCK
    scale = HEAD_DIM ** -0.5
    qb = jnp.moveaxis(q.reshape(b, nb, ATTN_BLOCK, N_KV_HEADS, Q_PER_KV, HEAD_DIM), 1, 0)

    def one_block(qblk):
        s = jnp.einsum('bqkgd,bskd->bkgqs', qblk, k).astype(jnp.float32) * scale
        p = _softmax_with_sink(s, sink)
        return jnp.einsum('bkgqs,bskd->bqkgd', p.astype(v.dtype), v)

    o = lax.map(one_block, qb)
    return jnp.moveaxis(o, 0, 1).reshape(b, n, ATTN_W)


def _latent_attention(q, k, v, ck, cv, sink):
    b, n, _, _ = q.shape
    nb = n // ATTN_BLOCK
    scale = HEAD_DIM ** -0.5
    pad = ((0, 0), (ATTN_BLOCK, ATTN_BLOCK), (0, 0), (0, 0))
    kp = jnp.pad(k, pad).reshape(b, nb + 2, ATTN_BLOCK, N_KV_HEADS, HEAD_DIM)
    vp = jnp.pad(v, pad).reshape(b, nb + 2, ATTN_BLOCK, N_KV_HEADS, HEAD_DIM)
    kb = jnp.concatenate([kp[:, :-2], kp[:, 1:-1], kp[:, 2:]], axis=2)
    vb = jnp.concatenate([vp[:, :-2], vp[:, 1:-1], vp[:, 2:]], axis=2)
    qb = q.reshape(b, nb, ATTN_BLOCK, N_KV_HEADS, Q_PER_KV, HEAD_DIM)
    blk = jnp.arange(nb)[:, None, None]
    qpos = blk * ATTN_BLOCK + jnp.arange(ATTN_BLOCK)[None, :, None]
    kpos = (blk - 1) * ATTN_BLOCK + jnp.arange(3 * ATTN_BLOCK)[None, None, :]
    valid = (jnp.abs(qpos - kpos) <= WINDOW) & (kpos >= 0) & (kpos < n)
    s_loc = jnp.einsum('bnqkgd,bnskd->bnkgqs', qb, kb).astype(jnp.float32) * scale
    s_loc = jnp.where(valid[None, :, None, None], s_loc, NEG_INF)
    s_ctx = jnp.einsum('bnqkgd,bskd->bnkgqs', qb, ck).astype(jnp.float32) * scale
    p = _softmax_with_sink(jnp.concatenate([s_loc, s_ctx], axis=-1), sink).astype(v.dtype)
    n_loc = 3 * ATTN_BLOCK
    o = (jnp.einsum('bnkgqs,bnskd->bnqkgd', p[..., :n_loc], vb)
         + jnp.einsum('bnkgqs,bskd->bnqkgd', p[..., n_loc:], cv))
    return o.reshape(b, n, ATTN_W)


def _centred_mean(x, size):
    n = x.shape[1]
    xf = x.astype(jnp.float32)
    cs = jnp.pad(jnp.cumsum(xf, axis=1), ((0, 0), (1, 0), (0, 0)))
    t = jnp.arange(n)
    half = size // 2
    lo = jnp.clip(t - half, 0, n)
    hi = jnp.clip(t + half, 0, n)
    cnt = (hi - lo).astype(jnp.float32)
    return (cs[:, hi] - cs[:, lo]) / cnt[None, :, None]


def _pool_mixer(xp, pool_w, pool_scale):
    b, n, _ = xp.shape
    groups = jnp.split(xp, POOL_GROUPS, axis=-1)
    pooled = jnp.concatenate([_centred_mean(g, s) for g, s in zip(groups, POOL_SIZES)], axis=-1)
    pooled = pooled.astype(xp.dtype) - xp
    y = jnp.einsum('blgc,gcd->blgd', pooled.reshape(b, n, POOL_GROUPS, POOL_GROUP_W), pool_w)
    return y.reshape(b, n, POOL_W) * pool_scale


def _conv_mixer(xc, conv_dw, conv_b, conv_norm, conv_pw):
    a, gate = jnp.split(xc, 2, axis=-1)
    u = a * jax.nn.sigmoid(gate)
    half = CONV_WIDTH // 2
    y = lax.conv_general_dilated(u, conv_dw[:, None, :], window_strides=(1,),
                                 padding=[(half, half)], dimension_numbers=('NWC', 'WIO', 'NWC'),
                                 feature_group_count=CONV_W) + conv_b
    y = jax.nn.silu(_rmsnorm(y, conv_norm))
    return y @ conv_pw


def _gmlp_mixer(xg, gm_norm, gm_ws, gm_b):
    b, n, _ = xg.shape
    u, v = jnp.split(jax.nn.gelu(xg), 2, axis=-1)
    v = _rmsnorm(v, gm_norm)
    vc = v.reshape(b, n // GM_CHUNK, GM_CHUNK, GM_GROUPS, GM_GROUP_W)
    sv = jnp.einsum('gpq,bnqgc->bnpgc', gm_ws, vc) + gm_b.T[None, None, :, :, None]
    return u * sv.reshape(b, n, GM_W)


def _token_mixers(h, p, ctx_kv, rope):
    b, n, _ = h.shape
    proj = h @ p['w_in']
    q, k, v, xp, xc, xg = jnp.split(proj, IN_SPLITS, axis=-1)
    q = q.reshape(b, n, N_Q_HEADS, HEAD_DIM)
    k = k.reshape(b, n, N_KV_HEADS, HEAD_DIM)
    v = v.reshape(b, n, N_KV_HEADS, HEAD_DIM)
    if ctx_kv is None:
        attn = _context_attention(q, k, v, p['attn_sink'])
    else:
        cos, sin = rope
        q = _apply_rope(q, cos, sin)
        k = _apply_rope(k, cos, sin)
        attn = _latent_attention(q, k, v, ctx_kv[0], ctx_kv[1], p['attn_sink'])
    pool = _pool_mixer(xp, p['pool_w'], p['pool_scale'])
    conv = _conv_mixer(xc, p['conv_dw'], p['conv_b'], p['conv_norm'], p['conv_pw'])
    gm = _gmlp_mixer(xg, p['gm_norm'], p['gm_ws'], p['gm_b'])
    mix = jnp.concatenate([attn, pool, conv, gm], axis=-1) @ p['w_out']
    return mix, k, v


def _layer(x, mod, p, ctx_kv, rope):
    sh1, sc1, g1, sh2, sc2, g2 = jnp.split(mod[:, None, :].astype(x.dtype), N_MOD, axis=-1)
    h = _rmsnorm(x, p['norm1']) * (1 + sc1) + sh1
    mix, k, v = _token_mixers(h, p, ctx_kv, rope)
    x = x + g1 * mix
    h = _rmsnorm(x, p['norm2']) * (1 + sc2) + sh2
    f = jnp.square(jax.nn.relu(h @ p['w_mlp1'])) @ p['w_mlp2']
    x = x + g2 * f
    return x, k, v


def setup_inputs(seed: int = 0) -> dict:
    key = jax.random.key(seed)
    ks = jax.random.split(key, 25)

    def nrm(k, shape, scale):
        return jax.random.normal(k, shape, jnp.float32) * scale

    def gain(k, shape):
        return 1.0 + 0.05 * jax.random.normal(k, shape, jnp.float32)

    cache_shape = (DEC_BATCH, DEPTH, PAST_LEN, N_KV_HEADS, HEAD_DIM)
    return {
        'x_prompt': nrm(ks[0], (BATCH, SEQ, D_MODEL), 1.0),
        'x_sample': nrm(ks[1], (DEC_BATCH, DEC_SEQ, D_MODEL), 1.0),
        'cache_k': nrm(ks[2], cache_shape, 1.0),
        'cache_v': nrm(ks[3], cache_shape, 1.0),
        'c': nrm(ks[4], (DEC_BATCH, D_MODEL), 1.0),
        'c_ctx': nrm(ks[5], (D_MODEL,), 1.0),
        'w_ada': nrm(ks[6], (DEPTH, D_MODEL, N_MOD * D_MODEL), 0.5 * D_MODEL ** -0.5),
        'b_ada': nrm(ks[7], (DEPTH, N_MOD * D_MODEL), 0.02),
        'norm1': gain(ks[8], (DEPTH, D_MODEL)),
        'norm2': gain(ks[9], (DEPTH, D_MODEL)),
        'w_in': nrm(ks[10], (DEPTH, D_MODEL, IN_W), D_MODEL ** -0.5),
        'w_out': nrm(ks[11], (DEPTH, MIX_W, D_MODEL), MIX_W ** -0.5),
        'attn_sink': nrm(ks[12], (DEPTH, N_Q_HEADS), 0.5),
        'pool_w': nrm(ks[13], (DEPTH, POOL_GROUPS, POOL_GROUP_W, POOL_GROUP_W), POOL_GROUP_W ** -0.5),
        'pool_scale': gain(ks[14], (DEPTH, POOL_W)),
        'conv_dw': nrm(ks[15], (DEPTH, CONV_WIDTH, CONV_W), CONV_WIDTH ** -0.5),
        'conv_b': nrm(ks[16], (DEPTH, CONV_W), 0.02),
        'conv_norm': gain(ks[17], (DEPTH, CONV_W)),
        'conv_pw': nrm(ks[18], (DEPTH, CONV_W, CONV_W), CONV_W ** -0.5),
        'gm_norm': gain(ks[19], (DEPTH, GM_W // 2 * 2 // 2 * 1 if False else GM_W)),
        'gm_ws': nrm(ks[20], (DEPTH, GM_GROUPS, GM_CHUNK, GM_CHUNK), GM_CHUNK ** -0.5),
        'gm_b': gain(ks[21], (DEPTH, GM_GROUPS, GM_CHUNK)),
        'w_mlp1': nrm(ks[22], (DEPTH, D_MODEL, D_FF), D_MODEL ** -0.5),
        'w_mlp2': nrm(ks[23], (DEPTH, D_FF, D_MODEL), D_FF ** -0.5),
        'final_norm': gain(ks[24], (D_MODEL,)),
    }


def reference(x_prompt, x_sample, cache_k, cache_v, c, c_ctx, w_ada, b_ada, norm1, norm2,
              w_in, w_out, attn_sink, pool_w, pool_scale, conv_dw, conv_b, conv_norm, conv_pw,
              gm_norm, gm_ws, gm_b, w_mlp1, w_mlp2, final_norm):
    rows = x_sample.shape[1] // GRID_W
    rope = _axial_rope_tables(rows)
    silu_ctx = jax.nn.silu(c_ctx)[None, :]
    silu_c = jax.nn.silu(c)
    xc_stream = x_prompt
    xs_stream = x_sample
    ks_out = []
    vs_out = []
    for l in range(DEPTH):
        p = {'norm1': norm1[l], 'norm2': norm2[l], 'w_in': w_in[l], 'w_out': w_out[l],
             'attn_sink': attn_sink[l], 'pool_w': pool_w[l], 'pool_scale': pool_scale[l],
             'conv_dw': conv_dw[l], 'conv_b': conv_b[l], 'conv_norm': conv_norm[l],
             'conv_pw': conv_pw[l], 'gm_norm': gm_norm[l], 'gm_ws': gm_ws[l], 'gm_b': gm_b[l],
             'w_mlp1': w_mlp1[l], 'w_mlp2': w_mlp2[l]}
        mod_ctx = silu_ctx @ w_ada[l] + b_ada[l]
        mod_lat = silu_c @ w_ada[l] + b_ada[l]
        xc_stream, k_ctx, v_ctx = _layer(xc_stream, mod_ctx, p, None, None)
        ks_out.append(k_ctx)
        vs_out.append(v_ctx)
        xs_stream, _, _ = _layer(xs_stream, mod_lat, p, (cache_k[:, l], cache_v[:, l]), rope)
    y_prompt = _rmsnorm(xc_stream, final_norm)
    y_sample = _rmsnorm(xs_stream, final_norm)
    new_k = jnp.stack(ks_out, axis=1)
    new_v = jnp.stack(vs_out, axis=1)
    return (y_prompt, y_sample, new_k, new_v)
```

```cpp
#include <hip/hip_runtime.h>
#include <hip/hip_cooperative_groups.h>
#include <cstdio>
#include <cstdint>
namespace cg = cooperative_groups;
#define MK_MULTI 0

namespace pg8 {
#define PG8_LAS __attribute__((address_space(3)))
typedef unsigned short bf16_t;
typedef short bf16x8 __attribute__((ext_vector_type(8)));
typedef float f32x4 __attribute__((ext_vector_type(4)));
typedef unsigned u32x4 __attribute__((ext_vector_type(4)));
constexpr int BM = 256, BK = 64, HALF = 128, HTB = HALF * BK * 2  , STAGE_BYTES = 8 * HTB, NXCD = 8, WGM = 8;

__host__ __device__ __forceinline__ int lds_byte(int r, int c) { const int st = (r >> 4) * 2 + (c >> 5), rr = r & 15, cc = c & 31, ob = rr * 64 + cc * 2; return st * 1024 + (ob ^ (((ob >> 9) & 1) << 5)); }
__host__ __device__ __forceinline__ void stage_rc(int b, int& R, int& C) { const int st = b / 1024, sb = b % 1024, swz = sb ^ (((sb >> 9) & 1) << 5); R = (st >> 1) * 16 + swz / 64; C = (st & 1) * 32 + (swz % 64) / 2; }
__host__ __device__ __forceinline__ int perm32(int rho) { const int n = rho >> 4, i = rho & 15; return 8 * (i >> 2) + 4 * n + (i & 3); }

struct Unit { int pm, pn, half; };
struct Gemm { const bf16_t* A; const bf16_t* Bt; int M, N, K; };

struct StreamOrder {
    int pm0, nM, nN, nwg, G, c, skipA, skipW, allHalf;
    __host__ __device__ void init(int pm0_, int nM_, int nN_, int G_, int c_, int skipA_, int skipW_, int allHalf_) { pm0 = pm0_; nM = nM_; nN = nN_; nwg = nM * nN; G = G_; c = c_; skipA = skipA_ < G_ ? skipA_ : G_ / 2; skipW = skipW_; allHalf = allHalf_; }
    __host__ __device__ bool next(int i, Unit& u) const {
        long L; u.half = -1;
        if (allHalf) { L = (long)i * (G >> 1) + (c >> 1); u.half = c & 1; if (c >= (G & ~1)) return false; }
        else { const int round = i + (c < skipA ? skipW : 0);
            if (round < skipW) L = (long)round * (G - skipA) + (c - skipA); else L = (long)skipW * (G - skipA) + (long)(round - skipW) * G + c; }
        if (L >= nwg) return false;
        int wgid = (int)L; { const int q = nwg / NXCD, r = nwg % NXCD, xcd = wgid % NXCD, off = wgid / NXCD; wgid = (xcd < r ? xcd * (q + 1) : r * (q + 1) + (xcd - r) * q) + off; }
        const int nig = WGM * nN, gid = wgid / nig, fm = gid * WGM, gsz = (nM - fm) < WGM ? (nM - fm) : WGM;
        u.pm = pm0 + fm + ((wgid % nig) % gsz); u.pn = (wgid % nig) / gsz; return true;
    }
    __device__ __forceinline__ void a_ready(const Unit&) const {}
    __device__ __forceinline__ void done(const Unit&) const {}
};
struct StaticOrder {
    int nM, nN, nwg, G, c;
    __host__ __device__ void init(int M, int N, int G_, int c_) { nM = M / BM; nN = N / BM; nwg = nM * nN; G = G_; c = c_; }
    __host__ __device__ bool next(int i, Unit& u) const {
        const int nfull = nwg / G, R = nwg % G; long L; u.half = -1;
        if (i < nfull) L = (long)i * G + c;
        else if (i == nfull && R > 0) { if (2 * R <= G) { if (c >= 2 * R) return false; L = (long)nfull * G + (c >> 1); u.half = c & 1; } else { if (c >= R) return false; L = (long)nfull * G + c; } }
        else return false;
        int wgid = (int)L; { const int q = nwg / NXCD, r = nwg % NXCD, xcd = wgid % NXCD, off = wgid / NXCD; wgid = (xcd < r ? xcd * (q + 1) : r * (q + 1) + (xcd - r) * q) + off; }
        const int nig = WGM * nN, gid = wgid / nig, fm = gid * WGM, gsz = (nM - fm) < WGM ? (nM - fm) : WGM;
        u.pm = fm + ((wgid % nig) % gsz); u.pn = (wgid % nig) / gsz; return true;
    }
    __device__ __forceinline__ void a_ready(const Unit&) const {}
    __device__ __forceinline__ void done(const Unit&) const {}
};

__device__ __forceinline__ unsigned cvt_pk_bf16(float lo, float hi) { unsigned r; asm volatile("v_cvt_pk_bf16_f32 %0, %1, %2" : "=v"(r) : "v"(lo), "v"(hi)); return r; }
typedef float f32x2 __attribute__((ext_vector_type(2)));
template <class Epi, class Sched, bool ALIGN_EPI = false, bool SP2 = false, int KC = 0>
__device__ __forceinline__ void gemm_phase(PG8_LAS unsigned char* lds, const Gemm g, const Sched& S, const Epi& E) {
    int tid_o = threadIdx.x; asm volatile("" : "+v"(tid_o)); const int tid = tid_o, wid = __builtin_amdgcn_readfirstlane(tid >> 6), lane = tid & 63, wr = wid >> 2, wc = wid & 3, fr = lane & 15, fq = lane >> 4;
    const int K = KC ? KC : g.K, nt = K / BK;
    unsigned voffA[2], voffB[2];
#pragma unroll
    for (int i = 0; i < 2; ++i) { int R, C; stage_rc(tid * 16 + i * 8192, R, C); const int Rb = Epi::PERM ? ((R & ~31) + perm32(R & 31)) : R;
        voffA[i] = (unsigned)(R * K + C) * 2u; voffB[i] = (unsigned)(Rb * K + C) * 2u; }
    const size_t kstep = (size_t)(BK * 2);
    const size_t hstep = (size_t)HALF * K * 2;
    const size_t tstep = 2 * hstep;
    const unsigned ldsw = (unsigned)wid * 1024u;
    const int aoff = lds_byte(wr * 64 + fr, fq * 8), boff = lds_byte(wc * 32 + fr, fq * 8);
#define PG8_SA(b, h) (((b) * 2 + (h)) * HTB)
#define PG8_SB(b, h) ((4 + (b) * 2 + (h)) * HTB)
#define PG8_STAGE(bufoff, gbase, voff) do { _Pragma("unroll") for (int _i = 0; _i < 2; ++_i) \
        __builtin_amdgcn_global_load_lds((const unsigned*)((const char*)(gbase) + (voff)[_i]), (PG8_LAS unsigned*)(lds + (bufoff) + ldsw + _i * 8192), 16, 0, 0); } while (0)
#define PG8_LDA(dst, b, h) do { _Pragma("unroll") for (int m = 0; m < 4; ++m) _Pragma("unroll") for (int k = 0; k < 2; ++k) dst[m][k] = *(const PG8_LAS bf16x8*)(lds + PG8_SA(b, h) + aoff + m * 2048 + k * 1024); } while (0)
#define PG8_LDB(dst, b, h) do { _Pragma("unroll") for (int n = 0; n < 2; ++n) _Pragma("unroll") for (int k = 0; k < 2; ++k) dst[n][k] = *(const PG8_LAS bf16x8*)(lds + PG8_SB(b, h) + boff + n * 2048 + k * 1024); } while (0)
#define PG8_MMA(ai, bj, At, Bt) do { __builtin_amdgcn_s_setprio(1); _Pragma("unroll") for (int m = 0; m < 4; ++m) _Pragma("unroll") for (int n = 0; n < 2; ++n) _Pragma("unroll") for (int k = 0; k < 2; ++k) \
        acc[ai][bj][m][n] = __builtin_amdgcn_mfma_f32_16x16x32_bf16(Bt[n][k], At[m][k], acc[ai][bj][m][n], 0, 0, 0); __builtin_amdgcn_s_setprio(0); } while (0)
#define PG8_WAIT_V(n) asm volatile("s_waitcnt vmcnt(" #n ")" ::: "memory")
#define PG8_WAIT_L(n) asm volatile("s_waitcnt lgkmcnt(" #n ")" ::: "memory")
#define PG8_BAR __builtin_amdgcn_s_barrier()
#define PG8_SCHED __builtin_amdgcn_sched_barrier(0)
    Unit cur, nxt; int ui = 0;
    if (!S.next(0, cur)) return;
    f32x4 acc[2][2][4][2];
    typename Epi::Pre epre;
#pragma unroll
    for (int a = 0; a < 2; ++a)
#pragma unroll
        for (int b = 0; b < 2; ++b)
#pragma unroll
            for (int m = 0; m < 4; ++m)
#pragma unroll
                for (int n = 0; n < 2; ++n) acc[a][b][m][n] = (f32x4){0.f, 0.f, 0.f, 0.f};
    bf16x8 At[4][2], B0[2][2], B1[2][2];
    const char* cA = (const char*)g.A + (size_t)cur.pm * tstep + (cur.half > 0 ? hstep : (size_t)0); const char* cB = (const char*)g.Bt + (size_t)cur.pn * tstep;
    S.a_ready(cur);
    if constexpr (SP2) {
        PG8_STAGE(PG8_SB(0, 0), cB, voffB); PG8_STAGE(PG8_SB(0, 1), cB + hstep, voffB); PG8_STAGE(PG8_SA(0, 0), cA, voffA); PG8_STAGE(PG8_SA(0, 1), cA + hstep, voffA);
        if (wr == 1) PG8_BAR;
        PG8_WAIT_V(2); PG8_BAR;
        PG8_STAGE(PG8_SB(1, 0), cB + kstep, voffB); PG8_STAGE(PG8_SA(1, 0), cA + kstep, voffA); PG8_STAGE(PG8_SB(1, 1), cB + hstep + kstep, voffB);
        PG8_WAIT_V(6); PG8_BAR;
    } else {
        PG8_STAGE(PG8_SB(0, 0), cB, voffB); PG8_STAGE(PG8_SA(0, 0), cA, voffA); PG8_STAGE(PG8_SB(0, 1), cB + hstep, voffB); PG8_STAGE(PG8_SA(0, 1), cA + hstep, voffA);
        if (wr == 1) PG8_BAR;
        PG8_WAIT_V(4); PG8_BAR;
        PG8_STAGE(PG8_SB(1, 0), cB + kstep, voffB); PG8_STAGE(PG8_SA(1, 0), cA + kstep, voffA); PG8_STAGE(PG8_SB(1, 1), cB + hstep + kstep, voffB);
        PG8_WAIT_V(6); PG8_BAR;
    }
    for (;;) {
        const bool has_next = S.next(ui + 1, nxt);
        const char* nA = has_next ? (const char*)g.A + (size_t)nxt.pm * tstep + (nxt.half > 0 ? hstep : (size_t)0) : cA; const char* nB = has_next ? (const char*)g.Bt + (size_t)nxt.pn * tstep : cB;
        for (int t = 0; t < nt; t += 2) {
            const bool last = (t == nt - 2);
            if (last) E.preload(epre, cur, wr, wc, fr, fq, lds);
            const char* a1 = cA + (size_t)(t + 1) * kstep;
            const char* a2 = last ? nA : cA + (size_t)(t + 2) * kstep; const char* b2 = last ? nB : cB + (size_t)(t + 2) * kstep;
            const char* a3 = a2 + kstep; const char* b3 = b2 + kstep;
            if (last && has_next) S.a_ready(nxt);
            if constexpr (SP2) {
            PG8_LDB(B0, 0, 0); PG8_LDB(B1, 0, 1); PG8_SCHED; PG8_LDA(At, 0, 0); PG8_STAGE(PG8_SA(1, 1), a1 + hstep, voffA);
            PG8_WAIT_V(8); PG8_WAIT_L(0); PG8_BAR; PG8_MMA(0, 0, At, B0); PG8_MMA(0, 1, At, B1); PG8_BAR; PG8_SCHED;
            PG8_LDA(At, 0, 1); PG8_STAGE(PG8_SB(0, 0), b2, voffB); PG8_STAGE(PG8_SB(0, 1), b2 + hstep, voffB); PG8_STAGE(PG8_SA(0, 0), a2, voffA);
            PG8_WAIT_V(8); PG8_WAIT_L(0); PG8_BAR; if (cur.half < 0) { PG8_MMA(1, 0, At, B0); PG8_MMA(1, 1, At, B1); } PG8_BAR; PG8_SCHED;
            PG8_LDB(B0, 1, 0); PG8_LDB(B1, 1, 1); PG8_SCHED; PG8_LDA(At, 1, 0); PG8_STAGE(PG8_SA(0, 1), a2 + hstep, voffA);
            PG8_WAIT_V(8); PG8_WAIT_L(0); PG8_BAR; PG8_MMA(0, 0, At, B0); PG8_MMA(0, 1, At, B1); PG8_BAR; PG8_SCHED;
            PG8_LDA(At, 1, 1); PG8_STAGE(PG8_SB(1, 0), b3, voffB); PG8_STAGE(PG8_SB(1, 1), b3 + hstep, voffB); PG8_STAGE(PG8_SA(1, 0), a3, voffA);
            PG8_WAIT_V(8); PG8_WAIT_L(0); PG8_BAR; if (cur.half < 0) { PG8_MMA(1, 0, At, B0); PG8_MMA(1, 1, At, B1); } PG8_BAR; PG8_SCHED;
            } else {
            PG8_LDB(B0, 0, 0); PG8_SCHED; PG8_LDA(At, 0, 0); PG8_STAGE(PG8_SA(1, 1), a1 + hstep, voffA);
            PG8_WAIT_L(8); PG8_BAR; PG8_WAIT_L(0); PG8_MMA(0, 0, At, B0); PG8_BAR; PG8_SCHED;
            PG8_LDB(B1, 0, 1); PG8_STAGE(PG8_SB(0, 0), b2, voffB);
            PG8_BAR; PG8_WAIT_L(0); PG8_MMA(0, 1, At, B1); PG8_BAR;
            PG8_LDA(At, 0, 1); PG8_STAGE(PG8_SA(0, 0), a2, voffA);
            PG8_BAR; PG8_WAIT_L(0); PG8_MMA(1, 0, At, B0); PG8_BAR; PG8_SCHED;
            PG8_STAGE(PG8_SB(0, 1), b2 + hstep, voffB);
            PG8_WAIT_V(6); PG8_BAR; PG8_MMA(1, 1, At, B1); PG8_BAR;
            PG8_LDB(B0, 1, 0); PG8_SCHED; PG8_LDA(At, 1, 0); PG8_STAGE(PG8_SA(0, 1), a2 + hstep, voffA);
            PG8_WAIT_L(8); PG8_BAR; PG8_WAIT_L(0); PG8_MMA(0, 0, At, B0); PG8_BAR; PG8_SCHED;
            PG8_LDB(B1, 1, 1); PG8_STAGE(PG8_SB(1, 0), b3, voffB);
            PG8_BAR; PG8_WAIT_L(0); PG8_MMA(0, 1, At, B1); PG8_BAR;
            PG8_LDA(At, 1, 1); PG8_STAGE(PG8_SA(1, 0), a3, voffA);
            PG8_BAR; PG8_WAIT_L(0); PG8_MMA(1, 0, At, B0); PG8_BAR; PG8_SCHED;
            PG8_STAGE(PG8_SB(1, 1), b3 + hstep, voffB);
            PG8_WAIT_V(6); PG8_BAR; PG8_MMA(1, 1, At, B1); PG8_BAR;
            }
        }
        if constexpr (ALIGN_EPI) { if (wr == 0) PG8_BAR; }
        if constexpr (!Epi::AFTER_DRAIN) { E(acc, cur, wr, wc, fr, fq, epre, lds); S.done(cur); }
        if (!has_next) break;
#pragma unroll
        for (int a = 0; a < 2; ++a)
#pragma unroll
            for (int b = 0; b < 2; ++b)
#pragma unroll
                for (int m = 0; m < 4; ++m)
#pragma unroll
                    for (int n = 0; n < 2; ++n) acc[a][b][m][n] = (f32x4){0.f, 0.f, 0.f, 0.f};
        cur = nxt; cA = nA; cB = nB; ++ui;
        if constexpr (ALIGN_EPI) { if (wr == 1) PG8_BAR; }
    }
    PG8_WAIT_V(0);
    if constexpr (!ALIGN_EPI) { if (wr == 0) PG8_BAR; }
    PG8_BAR;
    if constexpr (Epi::AFTER_DRAIN) { E.fused(acc, cur, wr, wc, fr, fq, lds, wid, lane); S.done(cur); }
#undef PG8_SA
#undef PG8_SB
#undef PG8_STAGE
#undef PG8_LDA
#undef PG8_LDB
#undef PG8_MMA
#undef PG8_WAIT_V
#undef PG8_WAIT_L
#undef PG8_BAR
#undef PG8_SCHED
}
}

#define LAS __attribute__((address_space(3)))
typedef unsigned short bf16_t;
typedef short bf16x8 __attribute__((ext_vector_type(8)));
typedef float f32x4 __attribute__((ext_vector_type(4)));
typedef float f32x2 __attribute__((ext_vector_type(2)));
typedef float f32x16 __attribute__((ext_vector_type(16)));
typedef unsigned u32x4 __attribute__((ext_vector_type(4)));
typedef unsigned u32x2 __attribute__((ext_vector_type(2)));

constexpr int DM = 1024, NCTX = 8192, MTOK = 40960, DEPTH = 4, INW = 1792, FF = 4096;
constexpr float EPS = 1e-6f, LOG2E = 1.4426950408889634f, QSCALE = 0.125f * 1.4426950408889634f;
constexpr size_t MiB = 1u << 20;
constexpr size_t WS_RSS = 482 * (size_t)(1u << 20);
typedef unsigned long long u64_t;
constexpr float RSS_SCALE = 16777216.f, RSS_INV = 1.f / 16777216.f;
__device__ __forceinline__ u64_t rss_fix(float s) { return (u64_t)(s * RSS_SCALE + 0.5f); }
__device__ __forceinline__ float rss_flt(u64_t v) { return (float)v * RSS_INV; }
constexpr size_t WS_MOD = 3 * MiB, WS_GV1 = 4 * MiB, WS_GV2 = 4 * MiB + 256 * 1024, WS_B1 = 4 * MiB + 512 * 1024, WS_B2 = 5 * MiB;
constexpr size_t WS_ROPE = 6 * MiB, WS_CK = 7 * MiB, WS_CV = 9 * MiB, WS_GMW = 11 * MiB, WS_BAR = 12 * MiB, WS_XCNT = 13 * MiB;
constexpr size_t WS_BT1 = 16 * MiB, WS_BT2 = 30 * MiB, WS_BT3 = 38 * MiB, WS_BT4 = 70 * MiB, WS_XG = 102 * MiB;
constexpr size_t WS_X16 = 182 * MiB;
constexpr size_t WS_PROJ = 262 * MiB, WS_MIX = 402 * MiB, WS_HC = 262 * MiB, WS_HL = 326 * MiB, WS_END = 490 * MiB;
constexpr int LDS_BYTES = 147456;
constexpr int NPHASE = 32;
constexpr int EPI_SCR = 131072 + 1024;

#ifndef SKIP_G1
#define SKIP_G1 0
#endif
#ifndef SKIP_G2
#define SKIP_G2 0
#endif
#ifndef SKIP_G3
#define SKIP_G3 0
#endif
#ifndef SKIP_G4
#define SKIP_G4 0
#endif
#ifndef SKIP_MIX
#define SKIP_MIX 0
#endif
#ifndef SKIP_P0
#define SKIP_P0 0
#endif
#ifndef P0A_REP
#define P0A_REP 1
#endif
#ifndef PROBE_REP
#define PROBE_REP 0
#define PROBE_J 5
#endif
#ifndef PROBE_NOSTORE
#define PROBE_NOSTORE 1
#endif
#ifndef PROBE_ONLY
#define PROBE_ONLY 15
#endif
#ifndef SYNC_REP
#define SYNC_REP 1
#endif
#ifndef MIX_REP
#define MIX_REP 1
#endif
#ifndef MIX_XLO
#define MIX_XLO 0
#define MIX_XHI 2880
#endif
#ifndef G3_REP
#define G3_REP 1
#endif
#ifndef P0_REP
#define P0_REP 1
#endif
#ifndef SKIP_ATT
#define SKIP_ATT 0
#endif
#ifndef SKIP_POOL
#define SKIP_POOL 0
#endif
#ifndef SKIP_CONV
#define SKIP_CONV 0
#endif
#ifndef SKIP_GM
#define SKIP_GM 0
#endif
struct Args { const float* in[25]; float* out; unsigned char* ws; int ph_lo, ph_hi; };
#define AS4 __attribute__((address_space(4)))
__device__ __forceinline__ const AS4 Args* kargs() { const AS4 Args* p = (const AS4 Args*)__builtin_amdgcn_kernarg_segment_ptr(); asm volatile("" : "+s"(p)); return p; }

__device__ __forceinline__ unsigned pkbf(float lo, float hi) { unsigned r; asm("v_cvt_pk_bf16_f32 %0, %1, %2" : "=v"(r) : "v"(lo), "v"(hi)); return r; }
__device__ __forceinline__ float bflo(unsigned w) { return __uint_as_float(w << 16); }
__device__ __forceinline__ float bfhi(unsigned w) { return __uint_as_float(w & 0xffff0000u); }
__device__ __forceinline__ float sigm(float x) { return __builtin_amdgcn_rcpf(1.f + __expf(-x)); }
__device__ __forceinline__ float gelu_t(float x) { return x * sigm(1.5957691216f * (x + 0.044715f * x * x * x)); }
__device__ __forceinline__ int modrow(int row) { return row < NCTX ? 0 : 1 + ((row - NCTX) >> 12); }
__device__ __forceinline__ int in_phys(int n) {
    if (n < 384) { const int j = n & 63; return (n & ~63) + 2 * (j & 31) + (j >> 5); }
    if (n >= 768 && n < 1024) { const int c = n - 768; return 768 + (c >> 7) * 256 + (c & 127); }
    if (n >= 1024 && n < 1280) { const int c = n - 1024; return 768 + (c >> 7) * 256 + 128 + (c & 127); }
    return n; }
template <int CTRL> __device__ __forceinline__ float dppf(float v) { return __builtin_bit_cast(float, __builtin_amdgcn_update_dpp(0, __builtin_bit_cast(int, v), CTRL, 0xf, 0xf, true)); }
__device__ __forceinline__ float wave_sum(float v) {
    v += dppf<0xB1>(v); v += dppf<0x4E>(v); v += dppf<0x141>(v); v += dppf<0x140>(v);
    const int iv = __builtin_bit_cast(int, v);
    return (__builtin_bit_cast(float, __builtin_amdgcn_readlane(iv, 0)) + __builtin_bit_cast(float, __builtin_amdgcn_readlane(iv, 16)))
         + (__builtin_bit_cast(float, __builtin_amdgcn_readlane(iv, 32)) + __builtin_bit_cast(float, __builtin_amdgcn_readlane(iv, 48)));
}
#define LDS_WAIT() asm volatile("s_waitcnt lgkmcnt(0)" ::: "memory")

struct EpiIn {
    static constexpr bool PERM = true, AFTER_DRAIN = false;
    int layer;
    struct Pre { int dummy; };
    __device__ __forceinline__ void preload(Pre&, const pg8::Unit& u, int wr, int wc, int fr, int fq, LAS unsigned char* lds) const {
        asm volatile("" : "+v"(fr), "+v"(fq)); asm volatile("" : "+s"(wr), "+s"(wc));
        const AS4 Args* ka = kargs(); unsigned char* ws = ka->ws;
        const unsigned* rss = (const unsigned*)((const u64_t*)(ws + WS_RSS) + (size_t)layer * MTOK); const float* bias = (const float*)(ws + WS_B1) + (size_t)layer * 9 * INW;
        const int pm = u.pm, pn = u.pn; const int mrow = pm < 32 ? 0 : 1 + ((pm - 32) >> 4);
        const int w = wr * 4 + wc, ln = fq * 16 + fr;
        if (w < 4) {
            __builtin_amdgcn_global_load_lds(rss + 2 * (size_t)(pm * 256 + w * 64 + ln), (LAS unsigned*)(lds + EPI_SCR + w * 256), 4, 0, 0);
            __builtin_amdgcn_global_load_lds(rss + 2 * (size_t)(pm * 256 + w * 64 + ln) + 1, (LAS unsigned*)(lds + EPI_SCR + 2048 + w * 256), 4, 0, 0);
        } else {
            __builtin_amdgcn_global_load_lds((const unsigned*)(bias + mrow * INW + pn * 256 + (w - 4) * 64 + ln), (LAS unsigned*)(lds + EPI_SCR + w * 256), 4, 0, 0);
            __builtin_amdgcn_global_load_lds((const unsigned*)(bias + mrow * INW + pn * 256 + (w - 4) * 64 + ln), (LAS unsigned*)(lds + EPI_SCR + 2048 + w * 256), 4, 0, 0);
        }
    }
    __device__ __forceinline__ void operator()(const f32x4 (&acc)[2][2][4][2], const pg8::Unit& u, int wr, int wc, int fr, int fq, const Pre&, LAS unsigned char* lds) const {
        asm volatile("" : "+v"(fr), "+v"(fq)); asm volatile("" : "+s"(wr), "+s"(wc));
        const LAS float* srs = (const LAS float*)(lds + EPI_SCR); const LAS float* sbi = (const LAS float*)(lds + EPI_SCR + 1024);
        struct { float rsv[2][4]; f32x4 bv[2][2]; } P;
#pragma unroll
        for (int bj = 0; bj < 2; ++bj)
#pragma unroll
            for (int n = 0; n < 2; ++n) P.bv[bj][n] = *(const LAS f32x4*)(sbi + bj * 128 + wc * 32 + 8 * fq + 4 * n);
#pragma unroll
        for (int ai = 0; ai < 2; ++ai)
#pragma unroll
            for (int m = 0; m < 4; ++m) { const int ri = (u.half >= 0 ? u.half : ai) * 128 + wr * 64 + m * 16 + fr; const LAS unsigned* su = (const LAS unsigned*)srs;
                P.rsv[ai][m] = rss_flt(((u64_t)su[512 + ri] << 32) | (u64_t)su[ri]); }
        const AS4 Args* ka = kargs(); unsigned char* ws = ka->ws; float* outp = ka->out;
        bf16_t* proj = (bf16_t*)(ws + WS_PROJ); const float* rss = (const float*)(ws + WS_RSS) + (size_t)layer * MTOK; const float* bias = (const float*)(ws + WS_B1) + (size_t)layer * 9 * INW;
        const float* rope = (const float*)(ws + WS_ROPE); u64_t* gmss = (u64_t*)(ws + WS_RSS) + (size_t)(9 + layer) * MTOK; float* newk = outp + (size_t)MTOK * DM; float* newv = newk + (size_t)32 * DEPTH * 256 * 128;
        const int pm = u.pm, pn = u.pn; const bool ctx = pm < 32; const int mrow = ctx ? 0 : 1 + ((pm - 32) >> 4);
        const int colw = wc * 32 + 8 * fq;
        f32x4 bv[2][2];
#pragma unroll
        for (int bj = 0; bj < 2; ++bj)
#pragma unroll
            for (int n = 0; n < 2; ++n) bv[bj][n] = P.bv[bj][n];
        const int i0 = (wc & 1) * 16 + 4 * fq;
        const bool ropeq = !ctx && pn == 0, ropek = !ctx && pn == 1;
#pragma unroll
        for (int ai = 0; ai < 2; ++ai) {
            if (ai == 1 && u.half >= 0) continue;
            const int rowb = pm * 256 + (u.half >= 0 ? u.half : ai) * 128 + wr * 64 + fr;
            float rsv[4]; f32x4 cs[4][2];
#pragma unroll
            for (int m = 0; m < 4; ++m) rsv[m] = P.rsv[ai][m];
            if (ropeq || ropek) {
#pragma unroll
                for (int m = 0; m < 4; ++m) { const int t = (rowb + m * 16 - NCTX) & 4095; cs[m][0] = *(const f32x4*)(rope + (size_t)(t * 32 + i0) * 2); cs[m][1] = *(const f32x4*)(rope + (size_t)(t * 32 + i0) * 2 + 4); }
            } else {
#pragma unroll
                for (int m = 0; m < 4; ++m) { cs[m][0] = (f32x4){1.f, 0.f, 1.f, 0.f}; cs[m][1] = (f32x4){1.f, 0.f, 1.f, 0.f}; }
            }
            asm volatile("" ::: "memory");
#pragma unroll
            for (int m = 0; m < 4; ++m) {
                const int row = rowb + m * 16;
                const float rs = rsqrtf(rsv[m] * (1.0f / DM) + EPS);
                float ssq = 0.f;
                if (pn == 3 || pn == 4) {
                    const f32x4 a0 = acc[ai][0][m][0] * rs + bv[0][0], a1 = acc[ai][0][m][1] * rs + bv[0][1], g0 = acc[ai][1][m][0] * rs + bv[1][0], g1 = acc[ai][1][m][1] * rs + bv[1][1];
                    u32x4 w; w.x = pkbf(a0[0] * sigm(g0[0]), a0[1] * sigm(g0[1])); w.y = pkbf(a0[2] * sigm(g0[2]), a0[3] * sigm(g0[3]));
                    w.z = pkbf(a1[0] * sigm(g1[0]), a1[1] * sigm(g1[1])); w.w = pkbf(a1[2] * sigm(g1[2]), a1[3] * sigm(g1[3]));
                    *(u32x4*)(proj + (size_t)row * INW + 768 + (pn - 3) * 128 + colw) = w;
                    continue;
                }
#pragma unroll
                for (int bj = 0; bj < 2; ++bj) {
                    f32x4 v0 = acc[ai][bj][m][0] * rs + bv[bj][0], v1 = acc[ai][bj][m][1] * rs + bv[bj][1];
                    const int col = pn * 256 + bj * 128 + colw;
                    const bool isq = (pn == 0), isk = (pn == 1 && bj == 0), isv = (pn == 1 && bj == 1);
                    if (isq || isk) {
                        if (!ctx) {
                            const f32x4 c0 = cs[m][0], c1 = cs[m][1];
                            f32x4 r0, r1;
                            r0[0] = v0[0] * c0[0] - v0[1] * c0[1]; r0[1] = v0[0] * c0[1] + v0[1] * c0[0];
                            r0[2] = v0[2] * c0[2] - v0[3] * c0[3]; r0[3] = v0[2] * c0[3] + v0[3] * c0[2];
                            r1[0] = v1[0] * c1[0] - v1[1] * c1[1]; r1[1] = v1[0] * c1[1] + v1[1] * c1[0];
                            r1[2] = v1[2] * c1[2] - v1[3] * c1[3]; r1[3] = v1[2] * c1[3] + v1[3] * c1[2];
                            v0 = r0; v1 = r1;
                        } else if (isk) {
                            const int b = row >> 8, t = row & 255, kvh = wc >> 1, j0 = (wc & 1) * 32 + 8 * fq;
                            float* o = newk + ((size_t)((b * DEPTH + layer) * 256 + t) * 2 + kvh) * 64 + (j0 >> 1);
                            *(f32x4*)o = (f32x4){v0[0], v0[2], v1[0], v1[2]};
                            *(f32x4*)(o + 32) = (f32x4){v0[1], v0[3], v1[1], v1[3]};
                        }
                        if (isq) { v0 = v0 * QSCALE; v1 = v1 * QSCALE; }
                    } else if (isv) {
                        if (ctx) {
                            const int b = row >> 8, t = row & 255, kvh = wc >> 1, j0 = (wc & 1) * 32 + 8 * fq;
                            float* o = newv + ((size_t)((b * DEPTH + layer) * 256 + t) * 2 + kvh) * 64 + j0;
                            *(f32x4*)o = v0; *(f32x4*)(o + 4) = v1;
                        }
                    } else if (pn >= 5) {
#pragma unroll
                        for (int e = 0; e < 4; ++e) { v0[e] = gelu_t(v0[e]); v1[e] = gelu_t(v1[e]); }
                        if (pn == 6) ssq += (v0[0] * v0[0] + v0[1] * v0[1]) + (v0[2] * v0[2] + v0[3] * v0[3]) + (v1[0] * v1[0] + v1[1] * v1[1]) + (v1[2] * v1[2] + v1[3] * v1[3]);
                    }
                    u32x4 w; w.x = pkbf(v0[0], v0[1]); w.y = pkbf(v0[2], v0[3]); w.z = pkbf(v1[0], v1[1]); w.w = pkbf(v1[2], v1[3]);
                    *(u32x4*)(proj + (size_t)row * INW + col) = w;
                }
                if (pn == 6) { ssq += __shfl_xor(ssq, 16); ssq += __shfl_xor(ssq, 32); if (fq == 0) atomicAdd(gmss + row, rss_fix(ssq)); }
            }
            asm volatile("" ::: "memory");
        }
    }
};

__device__ __forceinline__ bf16_t* hid_base(unsigned char* ws, int hsel) {
    return hsel == 0 ? (bf16_t*)(ws + WS_HC) : (bf16_t*)(ws + WS_HL) - (size_t)(NCTX + (hsel - 1) * 16384) * FF;
}
struct EpiRes {
    static constexpr bool PERM = true, AFTER_DRAIN = false;
    int layer, which;
    struct Pre { int dummy; };
    __device__ __forceinline__ void preload(Pre&, const pg8::Unit&, int, int, int, int, LAS unsigned char*) const {}
    __device__ __forceinline__ void operator()(const f32x4 (&acc)[2][2][4][2], const pg8::Unit& u, int wr, int wc, int fr, int fq, const Pre&, LAS unsigned char*) const {
        asm volatile("" : "+v"(fr), "+v"(fq)); asm volatile("" : "+s"(wr), "+s"(wc));
        const AS4 Args* ka = kargs(); unsigned char* ws = ka->ws;
        const bool first = (layer == 0 && which == 0), last = (layer == DEPTH - 1 && which == 1);
        const float* gate = (const float*)(ws + WS_MOD) + (size_t)layer * 9 * 6144 + (which == 0 ? 2048 : 5120);
        const float* gv = last ? nullptr : (which == 0 ? (const float*)(ws + WS_GV2) + (size_t)layer * 9 * DM : (const float*)(ws + WS_GV1) + (size_t)(layer + 1) * 9 * DM);
        bf16_t* xg = (bf16_t*)(ws + WS_XG); bf16_t* x16 = (bf16_t*)(ws + WS_X16); u64_t* rssn = (u64_t*)(ws + WS_RSS) + (size_t)(which == 0 ? 4 + layer : (last ? 8 : layer + 1)) * MTOK;
        const int pm = u.pm, pn = u.pn; const bool ctx = pm < 32; const int mrow = ctx ? 0 : 1 + ((pm - 32) >> 4);
        const int colw = pn * 256 + wc * 32 + 8 * fq;
        const float* xin = ctx ? ka->in[0] : ka->in[1] - (size_t)NCTX * DM;
        float ssr[2][4];
#pragma unroll
        for (int ai = 0; ai < 2; ++ai)
#pragma unroll
            for (int mq = 0; mq < 4; ++mq) ssr[ai][mq] = 0.f;
        const int nai = u.half >= 0 ? 1 : 2;
        u32x4 pre[2][2][2];
#define ERES_LOAD(slot, ai_, bj_, mh_) do { const int ah_ = u.half >= 0 ? u.half : (ai_); const size_t ob_ = (size_t)(pm * 256 + ah_ * 128 + wr * 64 + (mh_) * 32 + fr) * DM + colw + (bj_) * 128; \
        _Pragma("unroll") for (int mm = 0; mm < 2; ++mm) { if (first) { pre[slot][mm][0] = *(const u32x4*)(xin + ob_ + (size_t)mm * 16 * DM); pre[slot][mm][1] = *(const u32x4*)(xin + ob_ + (size_t)mm * 16 * DM + 4); } \
            else { pre[slot][mm][0] = *(const u32x4*)(x16 + ob_ + (size_t)mm * 16 * DM); pre[slot][mm][1] = pre[slot][mm][0]; } } } while (0)
        ERES_LOAD(0, 0, 0, 0);
#pragma unroll
        for (int ai = 0; ai < 2; ++ai)
#pragma unroll
        for (int bj = 0; bj < 2; ++bj) {
            if (ai < nai) {
            f32x4 gt[2], gg[2];
#pragma unroll
            for (int n = 0; n < 2; ++n) {
                gt[n] = *(const f32x4*)(gate + mrow * 6144 + colw + bj * 128 + 4 * n);
                gg[n] = gv ? *(const f32x4*)(gv + mrow * DM + colw + bj * 128 + 4 * n) : (f32x4){0.f, 0.f, 0.f, 0.f};
            }
#pragma unroll
            for (int mh = 0; mh < 2; ++mh) {
                const int slot = mh;
                const int ah = u.half >= 0 ? u.half : ai;
                const size_t offb = (size_t)(pm * 256 + ah * 128 + wr * 64 + mh * 32 + fr) * DM + colw + bj * 128;
                if (mh == 0) { ERES_LOAD(1, ai, bj, 1); } else if (bj == 0) { ERES_LOAD(0, ai, 1, 0); } else if (ai == 0 && nai == 2) { ERES_LOAD(0, 1, 0, 0); }
                asm volatile("" ::: "memory");
#pragma unroll
                for (int mm = 0; mm < 2; ++mm) {
                    const int mq = mh * 2 + mm;
                    const size_t off = offb + (size_t)mm * 16 * DM;
                    const u32x4 p0 = pre[slot][mm][0], p1 = pre[slot][mm][1];
                    f32x4 b0, b1;
                    if (first) { b0 = __builtin_bit_cast(f32x4, p0); b1 = __builtin_bit_cast(f32x4, p1); }
                    else { b0 = (f32x4){bflo(p0.x), bfhi(p0.x), bflo(p0.y), bfhi(p0.y)}; b1 = (f32x4){bflo(p0.z), bfhi(p0.z), bflo(p0.w), bfhi(p0.w)}; }
                    const f32x4 x0 = b0 + gt[0] * acc[ai][bj][mq][0], x1 = b1 + gt[1] * acc[ai][bj][mq][1];
                    u32x4 xw; xw.x = pkbf(x0[0], x0[1]); xw.y = pkbf(x0[2], x0[3]); xw.z = pkbf(x1[0], x1[1]); xw.w = pkbf(x1[2], x1[3]);
                    *(u32x4*)(x16 + off) = xw;
                    ssr[ai][mq] += (x0[0] * x0[0] + x0[1] * x0[1]) + (x0[2] * x0[2] + x0[3] * x0[3]) + (x1[0] * x1[0] + x1[1] * x1[1]) + (x1[2] * x1[2] + x1[3] * x1[3]);
                    if (gv) {
                        const f32x4 y0 = x0 * gg[0], y1 = x1 * gg[1];
                        u32x4 w; w.x = pkbf(y0[0], y0[1]); w.y = pkbf(y0[2], y0[3]); w.z = pkbf(y1[0], y1[1]); w.w = pkbf(y1[2], y1[3]);
                        *(u32x4*)(xg + off) = w;
                    }
                }
                asm volatile("" ::: "memory");
            }
            }
        }
#undef ERES_LOAD
#pragma unroll
        for (int ai = 0; ai < 2; ++ai)
#pragma unroll
            for (int mq = 0; mq < 4; ++mq) {
                if (ai < nai) {
                    const int ah = u.half >= 0 ? u.half : ai;
                    float ss = ssr[ai][mq]; ss += __shfl_xor(ss, 16); ss += __shfl_xor(ss, 32);
                    if (fq == 0) atomicAdd(rssn + pm * 256 + ah * 128 + wr * 64 + mq * 16 + fr, rss_fix(ss));
                }
            }
    }
};

struct EpiUp {
    static constexpr bool PERM = true, AFTER_DRAIN = false;
    int layer; int nostore; int hsel;
    struct Pre { int dummy; };
    __device__ __forceinline__ void preload(Pre&, const pg8::Unit& u, int wr, int wc, int fr, int fq, LAS unsigned char* lds) const {
        asm volatile("" : "+v"(fr), "+v"(fq)); asm volatile("" : "+s"(wr), "+s"(wc));
        const AS4 Args* ka = kargs(); unsigned char* ws = ka->ws;
        const unsigned* rss = (const unsigned*)((const u64_t*)(ws + WS_RSS) + (size_t)(4 + layer) * MTOK); const float* bias = (const float*)(ws + WS_B2) + (size_t)layer * 9 * FF;
        const int pm = u.pm, pn = u.pn; const int mrow = pm < 32 ? 0 : 1 + ((pm - 32) >> 4);
        const int w = wr * 4 + wc, ln = fq * 16 + fr;
        if (w < 4) {
            __builtin_amdgcn_global_load_lds(rss + 2 * (size_t)(pm * 256 + w * 64 + ln), (LAS unsigned*)(lds + EPI_SCR + w * 256), 4, 0, 0);
            __builtin_amdgcn_global_load_lds(rss + 2 * (size_t)(pm * 256 + w * 64 + ln) + 1, (LAS unsigned*)(lds + EPI_SCR + 2048 + w * 256), 4, 0, 0);
        } else {
            __builtin_amdgcn_global_load_lds((const unsigned*)(bias + mrow * FF + pn * 256 + (w - 4) * 64 + ln), (LAS unsigned*)(lds + EPI_SCR + w * 256), 4, 0, 0);
            __builtin_amdgcn_global_load_lds((const unsigned*)(bias + mrow * FF + pn * 256 + (w - 4) * 64 + ln), (LAS unsigned*)(lds + EPI_SCR + 2048 + w * 256), 4, 0, 0);
        }
    }
    __device__ __forceinline__ void operator()(const f32x4 (&acc)[2][2][4][2], const pg8::Unit& u, int wr, int wc, int fr, int fq, const Pre&, LAS unsigned char* lds) const {
        asm volatile("" : "+v"(fr), "+v"(fq)); asm volatile("" : "+s"(wr), "+s"(wc));
        const AS4 Args* ka = kargs(); unsigned char* ws = ka->ws;
        bf16_t* h = hid_base(ws, hsel);
        const int pm = u.pm, pn = u.pn;
        const int colw = pn * 256 + wc * 32 + 8 * fq;
        const LAS float* srs = (const LAS float*)(lds + EPI_SCR); const LAS float* sbi = (const LAS float*)(lds + EPI_SCR + 1024);
        struct { float rsv[2][4]; f32x4 bv[2][2]; } P;
#pragma unroll
        for (int bj = 0; bj < 2; ++bj)
#pragma unroll
            for (int n = 0; n < 2; ++n) P.bv[bj][n] = *(const LAS f32x4*)(sbi + bj * 128 + wc * 32 + 8 * fq + 4 * n);
#pragma unroll
        for (int ai = 0; ai < 2; ++ai)
#pragma unroll
            for (int m = 0; m < 4; ++m) { const int ri = (u.half >= 0 ? u.half : ai) * 128 + wr * 64 + m * 16 + fr; const LAS unsigned* su = (const LAS unsigned*)srs;
                P.rsv[ai][m] = rss_flt(((u64_t)su[512 + ri] << 32) | (u64_t)su[ri]); }
        if (nostore) return;
#pragma unroll
        for (int ai = 0; ai < 2; ++ai)
#pragma unroll
            for (int m = 0; m < 4; ++m) {
                if (ai == 1 && u.half >= 0) continue;
                const int row = pm * 256 + (u.half >= 0 ? u.half : ai) * 128 + wr * 64 + m * 16 + fr;
                const float rs = rsqrtf(P.rsv[ai][m] * (1.0f / DM) + EPS);
#pragma unroll
                for (int bj = 0; bj < 2; ++bj) {
                    f32x4 v0 = acc[ai][bj][m][0] * rs + P.bv[bj][0], v1 = acc[ai][bj][m][1] * rs + P.bv[bj][1];
                    const f32x4 r0 = __builtin_elementwise_max(v0, (f32x4){0.f, 0.f, 0.f, 0.f}), r1 = __builtin_elementwise_max(v1, (f32x4){0.f, 0.f, 0.f, 0.f});
                    v0 = r0 * v0; v1 = r1 * v1;
                    u32x4 w; w.x = pkbf(v0[0], v0[1]); w.y = pkbf(v0[2], v0[3]); w.z = pkbf(v1[0], v1[1]); w.w = pkbf(v1[2], v1[3]);
                    *(u32x4*)(h + (size_t)row * FF + colw + bj * 128) = w;
                }
            }
    }
};

__device__ __forceinline__ void transpose_item(const float* W, int ldw, int k0, int n0, bf16_t* WT, int ldt, bool perm, LAS float* scr, int lane) {
    float tv[32];
#pragma unroll
    for (int i = 0; i < 32; ++i) { const int kk = 2 * i + (lane >> 5); tv[i] = W[(size_t)(k0 + kk) * ldw + n0 + (lane & 31)]; }
#pragma unroll
    for (int i = 0; i < 32; ++i) { const int kk = 2 * i + (lane >> 5); scr[kk * 33 + (lane & 31)] = tv[i]; }
    LDS_WAIT();
    const int c = lane & 7;
#pragma unroll
    for (int j = 0; j < 4; ++j) {
        const int n = (lane >> 3) + 8 * j; const LAS float* s = scr + (8 * c) * 33 + n;
        u32x4 o; o.x = pkbf(s[0 * 33], s[1 * 33]); o.y = pkbf(s[2 * 33], s[3 * 33]); o.z = pkbf(s[4 * 33], s[5 * 33]); o.w = pkbf(s[6 * 33], s[7 * 33]);
        const int nr = perm ? in_phys(n0 + n) : (n0 + n);
        *(u32x4*)(WT + (size_t)nr * ldt + k0 + 8 * c) = o;
    }
    LDS_WAIT();
}

__device__ __forceinline__ void gemv9_block(LAS float* sIn, LAS float* red, const float* W, int ldw, int n0, const float* badd, float* out, int ldo, bool perm, int tid) {
    const int wid = tid >> 6, lane = tid & 63;
    float acc[9];
#pragma unroll
    for (int r = 0; r < 9; ++r) acc[r] = 0.f;
    const float* wp = W + (size_t)(wid * 128) * ldw + n0 + lane;
    float wv[2][32];
#pragma unroll
    for (int i = 0; i < 32; ++i) wv[0][i] = wp[(size_t)i * ldw];
#pragma unroll
    for (int c = 0; c < 4; ++c) {
        if (c + 1 < 4) {
#pragma unroll
            for (int i = 0; i < 32; ++i) wv[(c + 1) & 1][i] = wp[(size_t)((c + 1) * 32 + i) * ldw];
        }
#pragma unroll
        for (int k4 = 0; k4 < 8; ++k4) {
            const float w0 = wv[c & 1][4 * k4], w1 = wv[c & 1][4 * k4 + 1], w2 = wv[c & 1][4 * k4 + 2], w3 = wv[c & 1][4 * k4 + 3];
#pragma unroll
            for (int r = 0; r < 9; ++r) { const f32x4 s = *(const LAS f32x4*)(sIn + r * 1024 + wid * 128 + c * 32 + 4 * k4); acc[r] += (s[0] * w0 + s[1] * w1) + (s[2] * w2 + s[3] * w3); }
        }
    }
#pragma unroll
    for (int r = 0; r < 9; ++r) red[(wid * 9 + r) * 64 + lane] = acc[r];
    __syncthreads();
    for (int idx = tid; idx < 576; idx += 512) {
        const int r = idx >> 6, c = idx & 63; float s = 0.f;
#pragma unroll
        for (int w = 0; w < 8; ++w) s += red[(w * 9 + r) * 64 + c];
        const int nn = n0 + c; if (badd) s += badd[nn];
        out[(size_t)r * ldo + (perm ? in_phys(nn) : nn)] = s;
    }
    __syncthreads();
}


template <int HALF> __device__ __forceinline__ void pool_run(const bf16_t* proj, bf16_t* mix, int s0, int n, int t0, int cv) {
    constexpr int NR = 7 + 2 * HALF;
    u32x4 r[NR];
#pragma unroll
    for (int k = 0; k < NR; ++k) { const int row = t0 - HALF + k; const int rc = min(max(row, 0), n - 1);
        const u32x4 v = *(const u32x4*)(proj + (size_t)(s0 + rc) * INW + 512 + cv * 8); const unsigned msk = (row >= 0 && row < n) ? 0xffffffffu : 0u;
        r[k] = (u32x4){v.x & msk, v.y & msk, v.z & msk, v.w & msk}; }
    float S[8];
#pragma unroll
    for (int e = 0; e < 8; ++e) S[e] = 0.f;
#pragma unroll
    for (int k = 0; k < 2 * HALF; ++k) { S[0] += bflo(r[k].x); S[1] += bfhi(r[k].x); S[2] += bflo(r[k].y); S[3] += bfhi(r[k].y); S[4] += bflo(r[k].z); S[5] += bfhi(r[k].z); S[6] += bflo(r[k].w); S[7] += bfhi(r[k].w); }
#pragma unroll
    for (int e = 0; e < 8; ++e) {
        const int t = t0 + e; const int a = max(t - HALF, 0), b = min(t + HALF, n); const float ic = __builtin_amdgcn_rcpf((float)(b - a));
        const u32x4 c = r[HALF + e];
        u32x4 o; o.x = pkbf(S[0] * ic - bflo(c.x), S[1] * ic - bfhi(c.x)); o.y = pkbf(S[2] * ic - bflo(c.y), S[3] * ic - bfhi(c.y));
        o.z = pkbf(S[4] * ic - bflo(c.z), S[5] * ic - bfhi(c.z)); o.w = pkbf(S[6] * ic - bflo(c.w), S[7] * ic - bfhi(c.w));
        *(u32x4*)(mix + (size_t)(s0 + t) * DM + 256 + cv * 8) = o;
        if (e < 7) { const u32x4 p = r[2 * HALF + e], q = r[e];
            S[0] += bflo(p.x) - bflo(q.x); S[1] += bfhi(p.x) - bfhi(q.x); S[2] += bflo(p.y) - bflo(q.y); S[3] += bfhi(p.y) - bfhi(q.y);
            S[4] += bflo(p.z) - bflo(q.z); S[5] += bfhi(p.z) - bfhi(q.z); S[6] += bflo(p.w) - bflo(q.w); S[7] += bfhi(p.w) - bfhi(q.w); }
    }
}
#define XB_TMO      128
#define XB_XCNT(j)  (256  + 64 * (j))
#define XB_XSUB(j)  (1280 + 64 * (j))
#define XB_XGEN(j)  (2304 + 64 * (j))
#define XB_TOP      3328
#define XB_TOPGEN   3392
#define XCD_BAR_WORDS 3456
#define XB_SPIN_CAP (1u << 18)

__device__ __forceinline__ unsigned xb_ld(unsigned* p)              { return __hip_atomic_load(p, __ATOMIC_RELAXED, __HIP_MEMORY_SCOPE_AGENT); }
__device__ __forceinline__ unsigned xb_add(unsigned* p, unsigned v) { return __hip_atomic_fetch_add(p, v, __ATOMIC_RELAXED, __HIP_MEMORY_SCOPE_AGENT); }
__device__ __forceinline__ unsigned xb_xcc_id() { return (unsigned)__builtin_amdgcn_s_getreg((3 << 11) | 20) & 0xFu; }
#define XB_SPIN(cond, bar) do { unsigned _sp = 0; while (cond) { __builtin_amdgcn_s_sleep(1); \
    if ((++_sp & 255u) == 0u) { if (xb_ld(&(bar)[XB_TMO])) break; if (_sp > XB_SPIN_CAP) { atomicAdd(&(bar)[XB_TMO], 1u); break; } } } } while (0)

struct XcdBarrier {
    unsigned* bar; unsigned x;
    volatile LAS unsigned* st;
};

__device__ __forceinline__ XcdBarrier xcd_barrier_post(unsigned* bar, volatile LAS unsigned* st) {
    XcdBarrier b; b.bar = bar; b.x = xb_xcc_id(); b.st = st;
    if (threadIdx.x == 0) (void)xb_add(&bar[XB_XCNT(b.x)], 1u);
    return b;
}
__device__ __forceinline__ void xcd_barrier_complete(unsigned* bar, unsigned x, unsigned& nloc, unsigned& nx) {
    const unsigned G = gridDim.x * gridDim.y * gridDim.z;
    unsigned sum, cnt, mine, sp = 0u;
    for (;;) {
        sum = 0u; cnt = 0u; mine = 0u;
#pragma unroll
        for (unsigned j = 0; j < 16; ++j) { const unsigned c = xb_ld(&bar[XB_XCNT(j)]); sum += c; cnt += (c > 0u) ? 1u : 0u; mine = (j == x) ? c : mine; }
        if (sum == G) break;
        __builtin_amdgcn_s_sleep(1);
        if ((++sp & 255u) == 0u) { if (xb_ld(&bar[XB_TMO])) break; if (sp > XB_SPIN_CAP) { atomicAdd(&bar[XB_TMO], 1u); break; } }
    }
    nloc = mine > 0u ? mine : 1u; nx = cnt > 0u ? cnt : 1u;
}

__device__ __forceinline__ void xcd_barrier(const XcdBarrier& b) {
    asm volatile("s_waitcnt vmcnt(0)" ::: "memory");
    __syncthreads();
    if (threadIdx.x == 0) {
        unsigned* bar = b.bar;
        __builtin_amdgcn_s_waitcnt(0);
        unsigned nloc = b.st[0], nx = b.st[1];
        if (nloc == 0u) { xcd_barrier_complete(bar, b.x, nloc, nx); b.st[0] = nloc; b.st[1] = nx; }
        const unsigned old = xb_add(&bar[XB_XSUB(b.x)], 1u);
        const unsigned gen = old / nloc;
        if (old + 1u == (gen + 1u) * nloc) {
            __builtin_amdgcn_fence(__ATOMIC_RELEASE, "agent");
            asm volatile("s_waitcnt vmcnt(0)" ::: "memory");
            const unsigned og = xb_add(&bar[XB_TOP], 1u);
            const unsigned tg = og / nx;
            if (og + 1u == (tg + 1u) * nx) xb_add(&bar[XB_TOPGEN], 1u);
            else XB_SPIN(xb_ld(&bar[XB_TOPGEN]) == tg, bar);
            __builtin_amdgcn_fence(__ATOMIC_ACQUIRE, "agent");
            xb_add(&bar[XB_XGEN(b.x)], 1u);
            asm volatile("s_waitcnt vmcnt(0)" ::: "memory");
        } else {
            XB_SPIN(xb_ld(&bar[XB_XGEN(b.x)]) == gen, bar);
            __builtin_amdgcn_fence(__ATOMIC_ACQUIRE, "agent");
            asm volatile("s_waitcnt vmcnt(0)" ::: "memory");
        }
    }
    __syncthreads();
}


__device__ __forceinline__ int census_vcu(const unsigned* cnt, volatile LAS unsigned* cw, int G, int bid) {
    bool ok = (G % 8) == 0;
#pragma unroll
    for (int j = 0; j < 8; ++j) ok = ok && (__hip_atomic_load(cnt + j, __ATOMIC_RELAXED, __HIP_MEMORY_SCOPE_AGENT) == (unsigned)(G / 8));
    const unsigned x = cw[0], r = cw[1];
    return (ok && r < (unsigned)(G / 8)) ? (int)(r * 8u + x) : bid;
}
__device__ __forceinline__ unsigned char* opq(unsigned char* p) { asm volatile("" : "+s"(p)); return p; }
__global__ void __launch_bounds__(512, 2) fwd_kernel(Args args) {
    extern __shared__ __attribute__((aligned(16))) unsigned char lds_raw[];
    LAS unsigned char* lds = (LAS unsigned char*)lds_raw;
    const int tid = threadIdx.x, lane = tid & 63, wid = __builtin_amdgcn_readfirstlane(tid >> 6);
    const int G = gridDim.x, bid = blockIdx.x;
    const int lo = args.ph_lo, hi = args.ph_hi;
#define DECL_PTRS \
    int tid_p = threadIdx.x; asm volatile("" : "+v"(tid_p)); const int tid = tid_p, lane = tid & 63, wid = __builtin_amdgcn_readfirstlane(tid >> 6); (void)lane; (void)wid; \
    const AS4 Args* KA = kargs(); unsigned char* ws = KA->ws; float* out = KA->out; \
    const float* x_prompt = KA->in[0]; const float* x_sample = KA->in[1]; \
    u64_t* rssb = (u64_t*)(ws + WS_RSS); float* modb = (float*)(ws + WS_MOD); \
    float* gv1 = (float*)(ws + WS_GV1); float* gv2 = (float*)(ws + WS_GV2); \
    float* b1 = (float*)(ws + WS_B1); float* b2 = (float*)(ws + WS_B2); float* ropet = (float*)(ws + WS_ROPE); \
    bf16_t* ckb = (bf16_t*)(ws + WS_CK); bf16_t* cvb = (bf16_t*)(ws + WS_CV); bf16_t* gmw = (bf16_t*)(ws + WS_GMW); \
    bf16_t* Bt1 = (bf16_t*)(ws + WS_BT1); bf16_t* Bt2 = (bf16_t*)(ws + WS_BT2); bf16_t* Bt3 = (bf16_t*)(ws + WS_BT3); bf16_t* Bt4 = (bf16_t*)(ws + WS_BT4); \
    bf16_t* xg = (bf16_t*)(ws + WS_XG); bf16_t* proj = (bf16_t*)(ws + WS_PROJ); bf16_t* mix = (bf16_t*)(ws + WS_MIX); bf16_t* x16 = (bf16_t*)(ws + WS_X16); \
    float* newk = out + (size_t)MTOK * DM; float* newv = newk + (size_t)32 * DEPTH * 256 * 128; \
    (void)x_prompt; (void)x_sample; (void)rssb; (void)modb; (void)gv1; (void)gv2; (void)b1; (void)b2; (void)ropet; (void)ckb; (void)cvb; (void)gmw; (void)Bt1; (void)Bt2; (void)Bt3; (void)Bt4; (void)xg; (void)proj; (void)mix; (void)x16; (void)newk; (void)newv
#define IN(k) (lo <= (k) && (k) < hi)
    { volatile LAS unsigned* st0 = (volatile LAS unsigned*)(lds + 131072 + 64); if (tid < 2) st0[tid] = 0u; __syncthreads(); }
    XcdBarrier xbar; xbar.bar = (unsigned*)(kargs()->ws + WS_BAR); xbar.x = 0; xbar.st = (volatile LAS unsigned*)(lds + 131072 + 64);
    { volatile LAS unsigned* cw = (volatile LAS unsigned*)(lds + 131072 + 96);
      if (tid == 0) { const unsigned x = xb_xcc_id() & 7u; cw[0] = x; cw[1] = __hip_atomic_fetch_add((unsigned*)(kargs()->ws + WS_XCNT) + x, 1u, __ATOMIC_RELAXED, __HIP_MEMORY_SCOPE_AGENT); }
      __syncthreads(); }
    int vcu = bid;
    if (lo < hi - 1) xbar = xcd_barrier_post((unsigned*)(kargs()->ws + WS_BAR), (volatile LAS unsigned*)(lds + 131072 + 64));
    if (lo < -1) cg::this_grid().sync();
#define SEAM(k) do { if (IN(k) && IN((k) + 1)) { xcd_barrier(xbar); if ((k) == 0) vcu = census_vcu((const unsigned*)(kargs()->ws + WS_XCNT), (volatile LAS unsigned*)(lds + 131072 + 96), G, bid); } } while (0)

    for (int p0r = 0; p0r < P0A_REP; ++p0r)
    if (IN(0) && !SKIP_P0) {
        DECL_PTRS;
        LAS float* sIn = (LAS float*)lds; LAS float* red = (LAS float*)(lds + 36864);
        for (int i = tid; i < 9 * 1024; i += 512) { const int r = i >> 10, k = i & 1023; const float v = r == 0 ? KA->in[5][k] : KA->in[4][(r - 1) * 1024 + k]; sIn[i] = v / (1.f + expf(-v)); }
        __syncthreads();
        for (int it = bid; it < 4 * 96; it += G) { const int l = it / 96, nb = it % 96;
            gemv9_block(sIn, red, KA->in[6] + (size_t)l * 1024 * 6144, 6144, nb * 64, KA->in[7] + l * 6144, modb + (size_t)l * 9 * 6144, 6144, false, tid); }
        for (int it = bid; it < 512; it += G) {
            const int l = it >> 7, ty = (it >> 6) & 1, nb = (it >> 2) & 15, cb = it & 3; const int n = nb * 64 + lane;
            const float* wo = KA->in[11] + (size_t)l * DM * DM;
            float acc[8];
#pragma unroll
            for (int i = 0; i < 8; ++i) acc[i] = 0.f;
            int kdst;
            if (ty == 0) {
                const float* pw = KA->in[13] + ((size_t)(l * 4 + cb) * 64 + wid * 8) * 64; const float* ps = KA->in[14] + l * 256 + cb * 64;
#pragma unroll 16
                for (int d = 0; d < 64; ++d) { const float wv = wo[(size_t)(256 + cb * 64 + d) * DM + n] * ps[d];
#pragma unroll
                    for (int i = 0; i < 8; ++i) acc[i] += pw[i * 64 + d] * wv; }
                kdst = 256 + cb * 64 + wid * 8;
            } else {
                const float* cp = KA->in[18] + ((size_t)l * 256 + cb * 64 + wid * 8) * 256;
#pragma unroll 16
                for (int d = 0; d < 256; ++d) { const float wv = wo[(size_t)(512 + d) * DM + n];
#pragma unroll
                    for (int i = 0; i < 8; ++i) acc[i] += cp[i * 256 + d] * wv; }
                kdst = 512 + cb * 64 + wid * 8;
            }
            u32x4 o; o.x = pkbf(acc[0], acc[1]); o.y = pkbf(acc[2], acc[3]); o.z = pkbf(acc[4], acc[5]); o.w = pkbf(acc[6], acc[7]);
            *(u32x4*)(Bt2 + (size_t)l * DM * DM + (size_t)n * DM + kdst) = o;
        }
        __syncthreads();
        {
            LAS float* scr = (LAS float*)(lds + wid * 8448);
            const int gw = bid * 8 + wid, NGW = G * 8;
            for (int it = gw; it < 4 * 5248; it += NGW) {
                const int l = it / 5248; int r = it % 5248;
                if (r < 896) { transpose_item(KA->in[10] + (size_t)l * DM * INW, INW, (r / 56) * 64, (r % 56) * 32, Bt1 + (size_t)l * INW * DM, DM, true, scr, lane); continue; } r -= 896;
                if (r < 256) { const int kbi = r >> 5, kb = kbi < 4 ? kbi : kbi + 8; transpose_item(KA->in[11] + (size_t)l * DM * DM, DM, kb * 64, (r & 31) * 32, Bt2 + (size_t)l * DM * DM, DM, false, scr, lane); continue; } r -= 256;
                if (r < 2048) { transpose_item(KA->in[22] + (size_t)l * DM * FF, FF, (r >> 7) * 64, (r & 127) * 32, Bt3 + (size_t)l * FF * DM, DM, false, scr, lane); continue; } r -= 2048;
                transpose_item(KA->in[23] + (size_t)l * FF * DM, DM, (r >> 5) * 64, (r & 31) * 32, Bt4 + (size_t)l * DM * FF, FF, false, scr, lane);
            }
        }
        const int gt = bid * 512 + tid, GT = G * 512;
        for (int i = gt; i < 13 * MTOK; i += GT) rssb[i] = 0ull;
        for (int i = gt; i < 4 * 4 * 128 * 128 / 2; i += GT) { const f32x2 v = *(const f32x2*)(KA->in[20] + 2 * (size_t)i); ((unsigned*)gmw)[i] = pkbf(v[0], v[1]); }
        for (int i = gt; i < 4096 * 32; i += GT) { const int t = i >> 5, p = i & 31; const float pos = (float)(p < 16 ? (t >> 6) : (t & 63));
            const float inv = exp2f(-(float)(p & 15) * (13.287712379549449f / 16.0f)); const float a = pos * inv; ropet[2 * i] = cosf(a); ropet[2 * i + 1] = sinf(a); }
        for (int i = gt; i < 131072; i += GT) {
            const int j0 = (i & 7) * 8; const size_t hb0 = (size_t)(i >> 3) * 64;
            const f32x4 a = *(const f32x4*)(KA->in[2] + hb0 + (j0 >> 1)), b = *(const f32x4*)(KA->in[2] + hb0 + 32 + (j0 >> 1));
            u32x4 o; o.x = pkbf(a[0], b[0]); o.y = pkbf(a[1], b[1]); o.z = pkbf(a[2], b[2]); o.w = pkbf(a[3], b[3]);
            *(u32x4*)(ckb + hb0 + j0) = o;
            const f32x4 c = *(const f32x4*)(KA->in[3] + hb0 + j0), d = *(const f32x4*)(KA->in[3] + hb0 + j0 + 4);
            u32x4 q; q.x = pkbf(c[0], c[1]); q.y = pkbf(c[2], c[3]); q.z = pkbf(d[0], d[1]); q.w = pkbf(d[2], d[3]);
            *(u32x4*)(cvb + hb0 + j0) = q;
        }
    }
    SEAM(0);
    if (IN(1) && !SKIP_P0) {
        DECL_PTRS;
        const int gt = bid * 512 + tid, GT = G * 512;
        for (int i = gt; i < 4 * 9 * 1024; i += GT) { const int l = i / 9216, r = (i % 9216) >> 10, k = i & 1023; const float* mr = modb + (size_t)(l * 9 + r) * 6144;
            gv1[i] = KA->in[8][l * 1024 + k] * (1.f + mr[1024 + k]); gv2[i] = KA->in[9][l * 1024 + k] * (1.f + mr[4096 + k]); }
        LAS float* sIn = (LAS float*)lds; LAS float* red = (LAS float*)(lds + 36864);
        for (int it = bid; it < 368; it += G) {
            int l, nb, off; const float* W; int ldw; float* o; int ldo; bool perm;
            if (it < 112) { l = it / 28; nb = it % 28; off = 0; W = KA->in[10] + (size_t)l * DM * INW; ldw = INW; o = b1 + (size_t)l * 9 * INW; ldo = INW; perm = true; }
            else { const int j = it - 112; l = j >> 6; nb = j & 63; off = 3072; W = KA->in[22] + (size_t)l * DM * FF; ldw = FF; o = b2 + (size_t)l * 9 * FF; ldo = FF; perm = false; }
            for (int i = tid; i < 9 * 1024; i += 512) sIn[i] = modb[(size_t)(l * 9 + (i >> 10)) * 6144 + off + (i & 1023)];
            __syncthreads();
            gemv9_block(sIn, red, W, ldw, nb * 64, nullptr, o, ldo, perm, tid);
        }
        for (int row = bid * 8 + wid; row < MTOK; row += G * 8) {
            const float* src = row < NCTX ? x_prompt + (size_t)row * DM : x_sample + (size_t)(row - NCTX) * DM;
            const float* mr = modb + (size_t)modrow(row) * 6144 + 1024;
            float ss = 0.f;
#pragma unroll
            for (int j = 0; j < 4; ++j) { const int k = 4 * lane + 256 * j; const f32x4 v = *(const f32x4*)(src + k); const f32x4 g = *(const f32x4*)(KA->in[8] + k); const f32x4 s = *(const f32x4*)(mr + k);
                ss += (v[0] * v[0] + v[1] * v[1]) + (v[2] * v[2] + v[3] * v[3]);
                u32x2 w; w.x = pkbf(v[0] * g[0] * (1.f + s[0]), v[1] * g[1] * (1.f + s[1])); w.y = pkbf(v[2] * g[2] * (1.f + s[2]), v[3] * g[3] * (1.f + s[3]));
                *(u32x2*)(xg + (size_t)row * DM + k) = w; }
            ss = wave_sum(ss);
            if (lane == 0) rssb[row] = rss_fix(ss);
        }
    }
    SEAM(1);

#pragma unroll 1
    for (int s = 0; s < 1 + 14 * DEPTH; ++s) {
        int ty, st, ls, ph, grp = 0; bool endslot;
        if (s == 0) { ty = 0; st = 0; ls = 0; ph = 2; endslot = true; }
        else { const int lq = (s - 1) / 14, j = (s - 1) % 14; ph = 3 + 7 * lq + (j >> 1); endslot = (j & 1); ls = lq;
            ty = (j == 0 || j == 13) ? 0 : (j == 1 || j == 2) ? 1 : (j == 3 || j == 4) ? 2 : (j == 5 || j == 7 || j == 10) ? 3 : (j == 6 || j == 8 || j == 12) ? 4 : -1;
            st = (j == 0 || j == 2 || j == 4 || j == 7 || j == 8 || j == 10 || j == 12) ? 1 : 0;
            grp = (j == 10 || j == 12) ? 1 : 0;
            if (j == 13) ls = lq + 1; }
        const bool active = IN(ph) && ls < DEPTH;
#if PROBE_REP
        for (int prep = 0; prep < ((s > 0 && (s - 1) % 14 == PROBE_J) ? 2 : 1); ++prep) {
#endif
        if (active && ty == 0 && !SKIP_G1) {
            DECL_PTRS;
            pg8::Gemm g{xg, Bt1 + (size_t)ls * INW * DM, MTOK, INW, DM}; pg8::StreamOrder S; S.init(st ? 32 : 0, st ? 128 : 32, INW / 256, G, vcu, 0, 0, 0);
            EpiIn E{ls};
            pg8::gemm_phase<EpiIn, pg8::StreamOrder, true, true, DM>(lds, g, S, E);
        }
        if (active && ty == 1 && !SKIP_MIX) {
            DECL_PTRS;
            const int l = ls;
            const int nAtt = st ? 512 : 128, nPool = st ? 256 : 64, nConv = st ? 512 : 128, nGm = st ? 1024 : 256;
            const int oAtt = st ? 0 : 512, oPool = st ? 64 : 0, oConv = st ? 128 : 0, oGm = st ? 256 : 0;
            const int vbid = st ? vcu : (vcu >= (G >> 1) ? vcu - (G >> 1) : (1 << 28)); const int vG = st ? G : (G >> 1);
            for (int itl = vbid; itl < nAtt + nConv; itl += vG) {
                int it;
                if (itl < nAtt) it = oAtt + itl; else it = 960 + oConv + (itl - nAtt);
#if PROBE_REP
                if (prep && !(((it < 640) ? 1 : 2) & PROBE_ONLY)) continue;
#endif
                int tid_o = threadIdx.x; asm volatile("" : "+v"(tid_o)); const int tid = tid_o, lane = tid & 63, wid = __builtin_amdgcn_readfirstlane(tid >> 6);
                if (it < 640) {
#if !SKIP_ATT
                    const bool lat = it < 512; int rowbase, qb, kvh, bidx = 0;
                    if (lat) { bidx = it >> 6; qb = (it & 63) >> 1; kvh = it & 1; rowbase = NCTX + bidx * 4096; }
                    else { const int i = it - 512; rowbase = (i >> 2) * 256; qb = (i >> 1) & 1; kvh = i & 1; }
                    const int jlo = lat ? (qb == 0 ? 1 : 0) : 0, jhi = lat ? (qb == 31 ? 1 : 2) : 1, nloc = jhi - jlo + 1, ntiles = lat ? nloc + 2 : 2;
                    const int hi5 = lane >> 5, l31 = lane & 31;
                    const int g = wid >> 2, tq = (wid & 3) * 32 + l31, h = 2 * kvh + g;
                    const size_t qrow = (size_t)rowbase + qb * 128 + tq;
                    bf16x8 qf[4];
#pragma unroll
                    for (int ds = 0; ds < 4; ++ds) qf[ds] = *(const bf16x8*)(proj + qrow * INW + h * 64 + ds * 16 + hi5 * 8);
                    float mrun = KA->in[12][l * 4 + h] * LOG2E, lrun = hi5 == 0 ? 1.f : 0.f;
                    f32x16 o0, o1;
#pragma unroll
                    for (int r = 0; r < 16; ++r) { o0[r] = 0.f; o1[r] = 0.f; }
                    LAS unsigned char* Ks = lds; LAS unsigned char* Vt = lds + 18432;
                    u32x4 kreg[2], vreg[2];
                    auto tile_src = [&](int ti, const bf16_t*& kp, const bf16_t*& vp, int& pitch, int& mtype) {
                        if (lat && ti >= nloc) { const int c = ti - nloc; kp = ckb + ((size_t)((bidx * 4 + l) * 256 + c * 128) * 2 + kvh) * 64; vp = cvb + ((size_t)((bidx * 4 + l) * 256 + c * 128) * 2 + kvh) * 64; pitch = 128; mtype = 1; }
                        else { const int jb = lat ? jlo + ti : ti; const int kr = lat ? rowbase + (qb - 1 + jb) * 128 : rowbase + ti * 128; kp = proj + (size_t)kr * INW + 256 + kvh * 64; vp = kp + 128; pitch = INW; mtype = lat ? jb : 1; }
                    };
                    { const bf16_t *kp, *vp; int pitch, mt; tile_src(0, kp, vp, pitch, mt);
#pragma unroll
                      for (int i = 0; i < 2; ++i) { const int v = tid + 512 * i, key = v >> 3, cv = v & 7; kreg[i] = *(const u32x4*)(kp + (size_t)key * pitch + cv * 8); vreg[i] = *(const u32x4*)(vp + (size_t)key * pitch + cv * 8); } }
                    for (int ti = 0; ti < ntiles; ++ti) {
                        int mtype; { const bf16_t *kp, *vp; int pitch; tile_src(ti, kp, vp, pitch, mtype); }
                        __syncthreads();
#pragma unroll
                        for (int i = 0; i < 2; ++i) { const int v = tid + 512 * i, key = v >> 3, cv = v & 7;
                            *(LAS u32x4*)(Ks + key * 144 + cv * 16) = kreg[i];
                            LAS unsigned short* vd = (LAS unsigned short*)(Vt + (cv * 8) * 264 + key * 2);
                            vd[0 * 132] = (unsigned short)(vreg[i].x & 0xffff); vd[1 * 132] = (unsigned short)(vreg[i].x >> 16);
                            vd[2 * 132] = (unsigned short)(vreg[i].y & 0xffff); vd[3 * 132] = (unsigned short)(vreg[i].y >> 16);
                            vd[4 * 132] = (unsigned short)(vreg[i].z & 0xffff); vd[5 * 132] = (unsigned short)(vreg[i].z >> 16);
                            vd[6 * 132] = (unsigned short)(vreg[i].w & 0xffff); vd[7 * 132] = (unsigned short)(vreg[i].w >> 16); }
                        __syncthreads();
                        if (ti + 1 < ntiles) { const bf16_t *kp, *vp; int pitch, mt; tile_src(ti + 1, kp, vp, pitch, mt);
#pragma unroll
                            for (int i = 0; i < 2; ++i) { const int v = tid + 512 * i, key = v >> 3, cv = v & 7; kreg[i] = *(const u32x4*)(kp + (size_t)key * pitch + cv * 8); vreg[i] = *(const u32x4*)(vp + (size_t)key * pitch + cv * 8); } }
                        f32x16 p[4];
#pragma unroll
                        for (int kb = 0; kb < 4; ++kb) {
#pragma unroll
                            for (int r = 0; r < 16; ++r) p[kb][r] = 0.f;
#pragma unroll
                            for (int ds = 0; ds < 4; ++ds) { const bf16x8 a = *(const LAS bf16x8*)(Ks + (kb * 32 + l31) * 144 + ds * 32 + hi5 * 16); p[kb] = __builtin_amdgcn_mfma_f32_32x32x16_bf16(a, qf[ds], p[kb], 0, 0, 0); }
                        }
                        if (mtype != 1) {
                            const int dlo = (mtype == 0 ? tq : -1) - 4 * hi5, dhi = (mtype == 0 ? 1000 : tq) - 4 * hi5;
#pragma unroll
                            for (int kb = 0; kb < 4; ++kb)
#pragma unroll
                                for (int r = 0; r < 16; ++r) { const int j = kb * 32 + (r & 3) + 8 * (r >> 2); p[kb][r] = (j >= dlo && j <= dhi) ? p[kb][r] : -1e30f; }
                        }
                        float mx = -1e30f;
#pragma unroll
                        for (int kb = 0; kb < 4; ++kb)
#pragma unroll
                            for (int r = 0; r < 16; ++r) mx = fmaxf(mx, p[kb][r]);
                        mx = fmaxf(mx, __shfl_xor(mx, 32));
                        const float mnew = fmaxf(mrun, mx), alpha = __builtin_amdgcn_exp2f(mrun - mnew); mrun = mnew;
                        float rsum = 0.f;
#pragma unroll
                        for (int kb = 0; kb < 4; ++kb)
#pragma unroll
                            for (int r = 0; r < 16; ++r) { p[kb][r] = __builtin_amdgcn_exp2f(p[kb][r] - mnew); rsum += p[kb][r]; }
                        lrun = lrun * alpha + rsum;
#pragma unroll
                        for (int r = 0; r < 16; ++r) { o0[r] *= alpha; o1[r] *= alpha; }
#pragma unroll
                        for (int kb = 0; kb < 4; ++kb)
#pragma unroll
                            for (int j = 0; j < 2; ++j) {
                                u32x4 pw; pw.x = pkbf(p[kb][8 * j + 0], p[kb][8 * j + 1]); pw.y = pkbf(p[kb][8 * j + 2], p[kb][8 * j + 3]); pw.z = pkbf(p[kb][8 * j + 4], p[kb][8 * j + 5]); pw.w = pkbf(p[kb][8 * j + 6], p[kb][8 * j + 7]);
                                const bf16x8 pf = __builtin_bit_cast(bf16x8, pw);
                                const int kofs = (kb * 32 + 16 * j + 4 * hi5) * 2;
                                { const u32x2 a = *(const LAS u32x2*)(Vt + l31 * 264 + kofs), b = *(const LAS u32x2*)(Vt + l31 * 264 + kofs + 16);
                                  const u32x4 av = (u32x4){a.x, a.y, b.x, b.y}; o0 = __builtin_amdgcn_mfma_f32_32x32x16_bf16(__builtin_bit_cast(bf16x8, av), pf, o0, 0, 0, 0); }
                                { const u32x2 a = *(const LAS u32x2*)(Vt + (32 + l31) * 264 + kofs), b = *(const LAS u32x2*)(Vt + (32 + l31) * 264 + kofs + 16);
                                  const u32x4 av = (u32x4){a.x, a.y, b.x, b.y}; o1 = __builtin_amdgcn_mfma_f32_32x32x16_bf16(__builtin_bit_cast(bf16x8, av), pf, o1, 0, 0, 0); }
                            }
                    }
                    const float lt = lrun + __shfl_xor(lrun, 32), inv = 1.f / lt;
                    bf16_t* op = mix + qrow * DM + h * 64 + 4 * hi5;
#pragma unroll
                    for (int kq = 0; kq < 4; ++kq) {
                        u32x2 w0; w0.x = pkbf(o0[4 * kq] * inv, o0[4 * kq + 1] * inv); w0.y = pkbf(o0[4 * kq + 2] * inv, o0[4 * kq + 3] * inv); *(u32x2*)(op + 8 * kq) = w0;
                        u32x2 w1; w1.x = pkbf(o1[4 * kq] * inv, o1[4 * kq + 1] * inv); w1.y = pkbf(o1[4 * kq + 2] * inv, o1[4 * kq + 3] * inv); *(u32x2*)(op + 32 + 8 * kq) = w1;
                    }
                    __syncthreads();
#endif
                } else if (it < 1600) {
#if !SKIP_CONV
                    const int r0 = (it - 960) * 64; const int s0 = r0 < NCTX ? (r0 & ~255) : NCTX + ((r0 - NCTX) & ~4095); const int n = r0 < NCTX ? 256 : 4096;
                    LAS unsigned* U2 = (LAS unsigned*)lds;
                    LAS float* red = (LAS float*)(lds + 94 * 512);
                    const int c2 = tid & 127, tq4 = tid >> 7;
                    f32x2 wj[31];
#pragma unroll
                    for (int j = 0; j < 31; ++j) wj[j] = *(const f32x2*)(KA->in[15] + (size_t)(l * 31 + j) * 256 + 2 * c2);
                    const f32x2 cb = *(const f32x2*)(KA->in[16] + l * 256 + 2 * c2), gn = *(const f32x2*)(KA->in[17] + l * 256 + 2 * c2);
                    {
                        u32x4 av[6];
#pragma unroll
                        for (int i = 0; i < 6; ++i) { const int v = tid + 512 * i, tr = v >> 5, cv = v & 31, row = r0 + tr - 15; const bool ok = v < 94 * 32 && row >= s0 && row < s0 + n;
                            av[i] = ok ? *(const u32x4*)(proj + (size_t)row * INW + 768 + cv * 8) : (u32x4){0u, 0u, 0u, 0u}; }
#pragma unroll
                        for (int i = 0; i < 6; ++i) { const int v = tid + 512 * i, tr = v >> 5, cv = v & 31; if (v < 94 * 32) *(LAS u32x4*)(U2 + tr * 128 + cv * 4) = av[i]; }
                    }
                    __syncthreads();
                    f32x2 y[16];
#pragma unroll
                    for (int blk = 0; blk < 2; ++blk) {
                        const int t0 = tq4 * 16 + blk * 8;
                        f32x2 uu[38];
#pragma unroll
                        for (int k = 0; k < 38; ++k) { const unsigned w = U2[(t0 + k) * 128 + c2]; uu[k] = (f32x2){bflo(w), bfhi(w)}; }
#pragma unroll
                        for (int e = 0; e < 8; ++e) { f32x2 a = cb;
#pragma unroll
                            for (int j = 0; j < 31; ++j) a = __builtin_elementwise_fma(uu[e + j], wj[j], a);
                            y[blk * 8 + e] = a;
                            const float q = wave_sum(a[0] * a[0] + a[1] * a[1]);
                            if (lane == 0) red[(t0 + e) * 2 + (wid & 1)] = q; }
                    }
                    __syncthreads();
#pragma unroll
                    for (int e = 0; e < 16; ++e) { const int t = tq4 * 16 + e; const f32x2 q = *(const LAS f32x2*)(red + t * 2);
                        const float rs = rsqrtf((q[0] + q[1]) * (1.f / 256.f) + EPS); const float z0 = y[e][0] * rs * gn[0], z1 = y[e][1] * rs * gn[1];
                        *(unsigned*)(mix + (size_t)(r0 + t) * DM + 512 + 2 * c2) = pkbf(z0 * sigm(z0), z1 * sigm(z1)); }
                    __syncthreads();
#endif
                }
            }
            for (int wi = (vbid < (1 << 20) ? vbid * 8 + __builtin_amdgcn_readfirstlane(threadIdx.x >> 6) : (1 << 28)); wi < nPool * 8 + nGm * 2; wi += vG * 8) {
                int tid_o = threadIdx.x; asm volatile("" : "+v"(tid_o)); const int lane = tid_o & 63, wid = __builtin_amdgcn_readfirstlane(tid_o >> 6);
#if PROBE_REP
                if (prep && !(((wi < nPool * 8) ? 4 : 8) & PROBE_ONLY)) continue;
#endif
                if (wi < nPool * 8) {
                    const int pi = oPool + (wi >> 3), w = wi & 7;
                    const int r0 = pi * 128; const int s0 = r0 < NCTX ? (r0 & ~255) : NCTX + ((r0 - NCTX) & ~4095); const int n = r0 < NCTX ? 256 : 4096;
                    const int pg = w & 3, tb = (w >> 2) * 8 + (lane >> 3), cv = pg * 8 + (lane & 7), t0 = (r0 - s0) + tb * 8;
                    if (pg == 0) pool_run<1>(proj, mix, s0, n, t0, cv); else if (pg == 1) pool_run<2>(proj, mix, s0, n, t0, cv);
                    else if (pg == 2) pool_run<4>(proj, mix, s0, n, t0, cv); else pool_run<8>(proj, mix, s0, n, t0, cv);
                } else {
                    const int j = wi - nPool * 8, gi = oGm + (j >> 1), cb = j & 1, ch = gi >> 2, gq = gi & 3, r0 = ch * 128;
                    LAS unsigned char* Vt = lds + wid * 8704;
                    const u64_t* gss = rssb + (size_t)(9 + l) * MTOK;
                    const int hi5 = lane >> 5, l31 = lane & 31, cvq = lane & 3;
                    const int cbase = gq * 64 + cb * 32;
                    const f32x4 n0 = *(const f32x4*)(KA->in[19] + l * 256 + cbase + cvq * 8), n1 = *(const f32x4*)(KA->in[19] + l * 256 + cbase + cvq * 8 + 4);
                    u32x4 wv[8]; float rsq[8];
#pragma unroll
                    for (int i = 0; i < 8; ++i) { const int q = (lane >> 2) + 16 * i; wv[i] = *(const u32x4*)(proj + (size_t)(r0 + q) * INW + 1536 + cbase + cvq * 8); rsq[i] = rss_flt(gss[r0 + q]); }
                    bf16x8 bfr[4][8];
                    float gb[4];
#pragma unroll
                    for (int pbk = 0; pbk < 4; ++pbk) { gb[pbk] = KA->in[21][(l * 4 + gq) * 128 + pbk * 32 + l31];
#pragma unroll
                        for (int s2 = 0; s2 < 8; ++s2) bfr[pbk][s2] = *(const bf16x8*)(gmw + ((size_t)(l * 4 + gq) * 128 + pbk * 32 + l31) * 128 + s2 * 16 + hi5 * 8); }
#pragma unroll
                    for (int i = 0; i < 8; ++i) { const int q = (lane >> 2) + 16 * i; const float rs = rsqrtf(rsq[i] * (1.f / 256.f) + EPS); const u32x4 w = wv[i];
                        LAS unsigned short* vd = (LAS unsigned short*)(Vt + (cvq * 8) * 272 + q * 2);
                        vd[0 * 136] = (unsigned short)(pkbf(bflo(w.x) * rs * n0[0], 0.f) & 0xffff); vd[1 * 136] = (unsigned short)(pkbf(bfhi(w.x) * rs * n0[1], 0.f) & 0xffff);
                        vd[2 * 136] = (unsigned short)(pkbf(bflo(w.y) * rs * n0[2], 0.f) & 0xffff); vd[3 * 136] = (unsigned short)(pkbf(bfhi(w.y) * rs * n0[3], 0.f) & 0xffff);
                        vd[4 * 136] = (unsigned short)(pkbf(bflo(w.z) * rs * n1[0], 0.f) & 0xffff); vd[5 * 136] = (unsigned short)(pkbf(bfhi(w.z) * rs * n1[1], 0.f) & 0xffff);
                        vd[6 * 136] = (unsigned short)(pkbf(bflo(w.w) * rs * n1[2], 0.f) & 0xffff); vd[7 * 136] = (unsigned short)(pkbf(bfhi(w.w) * rs * n1[3], 0.f) & 0xffff); }
                    LDS_WAIT();
                    f32x16 sv[4];
#pragma unroll
                    for (int pbk = 0; pbk < 4; ++pbk)
#pragma unroll
                        for (int r = 0; r < 16; ++r) sv[pbk][r] = 0.f;
#pragma unroll
                    for (int s2 = 0; s2 < 8; ++s2) {
                        const bf16x8 a = *(const LAS bf16x8*)(Vt + l31 * 272 + (s2 * 16 + hi5 * 8) * 2);
#pragma unroll
                        for (int pbk = 0; pbk < 4; ++pbk) sv[pbk] = __builtin_amdgcn_mfma_f32_32x32x16_bf16(a, bfr[pbk][s2], sv[pbk], 0, 0, 0);
                    }
                    LDS_WAIT();
#pragma unroll
                    for (int pbk = 0; pbk < 4; ++pbk) {
                        const size_t prow = (size_t)(r0 + pbk * 32 + l31);
                        u32x2 uu[4];
#pragma unroll
                        for (int kq = 0; kq < 4; ++kq) uu[kq] = *(const u32x2*)(proj + prow * INW + 1280 + cbase + 8 * kq + 4 * hi5);
#pragma unroll
                        for (int kq = 0; kq < 4; ++kq) {
                            u32x2 o; o.x = pkbf(bflo(uu[kq].x) * (sv[pbk][4 * kq] + gb[pbk]), bfhi(uu[kq].x) * (sv[pbk][4 * kq + 1] + gb[pbk]));
                            o.y = pkbf(bflo(uu[kq].y) * (sv[pbk][4 * kq + 2] + gb[pbk]), bfhi(uu[kq].y) * (sv[pbk][4 * kq + 3] + gb[pbk]));
                            *(u32x2*)(mix + prow * DM + 768 + cbase + 8 * kq + 4 * hi5) = o; }
                    }
                }
            }
            __syncthreads();
        }
        if (active && ty == 2 && !SKIP_G2) {
            DECL_PTRS;
            pg8::Gemm g{mix, Bt2 + (size_t)ls * DM * DM, MTOK, DM, DM}; pg8::StreamOrder S; S.init(st ? 32 : 0, st ? 128 : 32, DM / 256, G, vcu, 0, 0, st ? 0 : 1);
            EpiRes E{ls, 0};
            pg8::gemm_phase<EpiRes, pg8::StreamOrder, true, true, DM>(lds, g, S, E);
        }
        if (active && ty == 3 && !SKIP_G3) {
            DECL_PTRS;
            const int hsel = st ? 1 + grp : 0;
            pg8::Gemm g{xg, Bt3 + (size_t)ls * FF * DM, MTOK, FF, DM}; pg8::StreamOrder S;
            S.init(st ? 32 + 64 * grp : 0, st ? 64 : 32, FF / 256, G, vcu, (st && grp == 0) ? 128 : 0, (st && grp == 0) ? 4 : 0, 0);
            EpiUp E{ls, 0, hsel};
            pg8::gemm_phase<EpiUp, pg8::StreamOrder, true, true, DM>(lds, g, S, E);
        }
        if (active && ty == 4 && !SKIP_G4) {
            DECL_PTRS;
            const int hsel = st ? 1 + grp : 0;
            pg8::Gemm g{hid_base(ws, hsel), Bt4 + (size_t)ls * DM * FF, MTOK, DM, FF}; pg8::StreamOrder S; S.init(st ? 32 + 64 * grp : 0, st ? 64 : 32, DM / 256, G, vcu, 0, 0, 0);
            EpiRes E{ls, 1};
            pg8::gemm_phase<EpiRes, pg8::StreamOrder, true, true, FF>(lds, g, S, E);
        }
#if PROBE_REP
        }
#endif
        if (endslot) SEAM(ph);
    }
    if (IN(31)) {
        DECL_PTRS;
        const u64_t* rf = rssb + (size_t)8 * MTOK;
        for (int row = bid * 8 + wid; row < MTOK; row += G * 8) {
            const float rs = rsqrtf(rss_flt(rf[row]) * (1.f / DM) + EPS);
#pragma unroll
            for (int j = 0; j < 2; ++j) { const int k = 8 * lane + 512 * j; const u32x4 w = *(const u32x4*)(x16 + (size_t)row * DM + k);
                const f32x4 g0 = *(const f32x4*)(KA->in[24] + k), g1 = *(const f32x4*)(KA->in[24] + k + 4);
                const f32x4 v0 = (f32x4){bflo(w.x), bfhi(w.x), bflo(w.y), bfhi(w.y)} * rs * g0, v1 = (f32x4){bflo(w.z), bfhi(w.z), bflo(w.w), bfhi(w.w)} * rs * g1;
                *(f32x4*)(out + (size_t)row * DM + k) = v0; *(f32x4*)(out + (size_t)row * DM + k + 4) = v1; }
        }
    }
#undef IN
#undef SEAM
}

#ifndef MK_MULTI
#define MK_MULTI 0
#endif
extern "C" void kernel_launch(void* const* d_in, const int* in_sizes, int n_in, void* d_out, int out_size, void* d_ws, size_t ws_size, hipStream_t stream) {
    static int grid = 0;
    if (grid == 0) {
        if (n_in != 25 || ws_size < WS_END) { fprintf(stderr, "kernel_launch: unexpected n_in %d / ws_size %zu\n", n_in, ws_size); grid = -1; return; }
        int dev = 0, cus = 0, per_cu = 0;
        hipGetDevice(&dev); hipDeviceGetAttribute(&cus, hipDeviceAttributeMultiprocessorCount, dev);
        if (hipFuncSetAttribute((const void*)fwd_kernel, hipFuncAttributeMaxDynamicSharedMemorySize, LDS_BYTES) != hipSuccess) { fprintf(stderr, "kernel_launch: hipFuncSetAttribute failed\n"); grid = -1; return; }
        if (hipOccupancyMaxActiveBlocksPerMultiprocessor(&per_cu, (const void*)fwd_kernel, 512, LDS_BYTES) != hipSuccess || per_cu < 1) per_cu = 1;
        (void)hipGetLastError();
        grid = cus * 1;
    }
    if (grid < 0) return;
    Args a{};
    for (int i = 0; i < 25; ++i) a.in[i] = (const float*)d_in[i];
    a.out = (float*)d_out; a.ws = (unsigned char*)d_ws;
#if MK_MULTI
    for (int p = 0; p < NPHASE; ++p) { a.ph_lo = p; a.ph_hi = p + 1; hipLaunchKernelGGL(fwd_kernel, dim3(grid), dim3(512), LDS_BYTES, stream, a); }
#else
    a.ph_lo = 0; a.ph_hi = NPHASE;
    (void)hipMemsetAsync((char*)d_ws + WS_XCNT, 0, 64, stream);
    (void)hipMemsetAsync((char*)d_ws + WS_BAR, 0, XCD_BAR_WORDS * 4, stream);
    void* kargs[] = {&a};
    hipError_t e = hipLaunchCooperativeKernel((const void*)fwd_kernel, dim3(grid), dim3(512), kargs, LDS_BYTES, stream);
    if (e != hipSuccess) fprintf(stderr, "cooperative launch failed: %s (grid %d)\n", hipGetErrorString(e), grid);
#endif
}
```

```cpp
#include <hip/hip_runtime.h>
#include <hip/hip_cooperative_groups.h>
#include <cstdio>
#include <cstdint>
namespace cg = cooperative_groups;
#define MK_MULTI 0

namespace pg8 {
#define PG8_LAS __attribute__((address_space(3)))
typedef unsigned short bf16_t;
typedef short bf16x8 __attribute__((ext_vector_type(8)));
typedef float f32x4 __attribute__((ext_vector_type(4)));
typedef unsigned u32x4 __attribute__((ext_vector_type(4)));
constexpr int BM = 256, BK = 64, HALF = 128, HTB = HALF * BK * 2  , STAGE_BYTES = 8 * HTB, NXCD = 8, WGM = 8;

__host__ __device__ __forceinline__ int lds_byte(int r, int c) { const int st = (r >> 4) * 2 + (c >> 5), rr = r & 15, cc = c & 31, ob = rr * 64 + cc * 2; return st * 1024 + (ob ^ (((ob >> 9) & 1) << 5)); }
__host__ __device__ __forceinline__ void stage_rc(int b, int& R, int& C) { const int st = b / 1024, sb = b % 1024, swz = sb ^ (((sb >> 9) & 1) << 5); R = (st >> 1) * 16 + swz / 64; C = (st & 1) * 32 + (swz % 64) / 2; }
__host__ __device__ __forceinline__ int perm32(int rho) { const int n = rho >> 4, i = rho & 15; return 8 * (i >> 2) + 4 * n + (i & 3); }

struct Unit { int pm, pn, half; };
struct Gemm { const bf16_t* A; const bf16_t* Bt; int M, N, K; };

struct StreamOrder {
    int pm0, nM, nN, nwg, G, c, skipA, skipW, allHalf;
    __host__ __device__ void init(int pm0_, int nM_, int nN_, int G_, int c_, int skipA_, int skipW_, int allHalf_) { pm0 = pm0_; nM = nM_; nN = nN_; nwg = nM * nN; G = G_; c = c_; skipA = skipA_ < G_ ? skipA_ : G_ / 2; skipW = skipW_; allHalf = allHalf_; }
    __host__ __device__ bool next(int i, Unit& u) const {
        long L; u.half = -1;
        if (allHalf) { L = (long)i * (G >> 1) + (c >> 1); u.half = c & 1; if (c >= (G & ~1)) return false; }
        else { const int round = i + (c < skipA ? skipW : 0);
            if (round < skipW) L = (long)round * (G - skipA) + (c - skipA); else L = (long)skipW * (G - skipA) + (long)(round - skipW) * G + c; }
        if (L >= nwg) return false;
        int wgid = (int)L; { const int q = nwg / NXCD, r = nwg % NXCD, xcd = wgid % NXCD, off = wgid / NXCD; wgid = (xcd < r ? xcd * (q + 1) : r * (q + 1) + (xcd - r) * q) + off; }
        const int nig = WGM * nN, gid = wgid / nig, fm = gid * WGM, gsz = (nM - fm) < WGM ? (nM - fm) : WGM;
        u.pm = pm0 + fm + ((wgid % nig) % gsz); u.pn = (wgid % nig) / gsz; return true;
    }
    __device__ __forceinline__ void a_ready(const Unit&) const {}
    __device__ __forceinline__ void done(const Unit&) const {}
};
struct StaticOrder {
    int nM, nN, nwg, G, c;
    __host__ __device__ void init(int M, int N, int G_, int c_) { nM = M / BM; nN = N / BM; nwg = nM * nN; G = G_; c = c_; }
    __host__ __device__ bool next(int i, Unit& u) const {
        const int nfull = nwg / G, R = nwg % G; long L; u.half = -1;
        if (i < nfull) L = (long)i * G + c;
        else if (i == nfull && R > 0) { if (2 * R <= G) { if (c >= 2 * R) return false; L = (long)nfull * G + (c >> 1); u.half = c & 1; } else { if (c >= R) return false; L = (long)nfull * G + c; } }
        else return false;
        int wgid = (int)L; { const int q = nwg / NXCD, r = nwg % NXCD, xcd = wgid % NXCD, off = wgid / NXCD; wgid = (xcd < r ? xcd * (q + 1) : r * (q + 1) + (xcd - r) * q) + off; }
        const int nig = WGM * nN, gid = wgid / nig, fm = gid * WGM, gsz = (nM - fm) < WGM ? (nM - fm) : WGM;
        u.pm = fm + ((wgid % nig) % gsz); u.pn = (wgid % nig) / gsz; return true;
    }
    __device__ __forceinline__ void a_ready(const Unit&) const {}
    __device__ __forceinline__ void done(const Unit&) const {}
};

__device__ __forceinline__ unsigned cvt_pk_bf16(float lo, float hi) { unsigned r; asm volatile("v_cvt_pk_bf16_f32 %0, %1, %2" : "=v"(r) : "v"(lo), "v"(hi)); return r; }
typedef float f32x2 __attribute__((ext_vector_type(2)));
template <class Epi, class Sched, bool ALIGN_EPI = false, bool SP2 = false, int KC = 0>
__device__ __forceinline__ void gemm_phase(PG8_LAS unsigned char* lds, const Gemm g, const Sched& S, const Epi& E) {
    int tid_o = threadIdx.x; asm volatile("" : "+v"(tid_o)); const int tid = tid_o, wid = __builtin_amdgcn_readfirstlane(tid >> 6), lane = tid & 63, wr = wid >> 2, wc = wid & 3, fr = lane & 15, fq = lane >> 4;
    const int K = KC ? KC : g.K, nt = K / BK;
    unsigned voffA[2], voffB[2];
#pragma unroll
    for (int i = 0; i < 2; ++i) { int R, C; stage_rc(tid * 16 + i * 8192, R, C); const int Rb = Epi::PERM ? ((R & ~31) + perm32(R & 31)) : R;
        voffA[i] = (unsigned)(R * K + C) * 2u; voffB[i] = (unsigned)(Rb * K + C) * 2u; }
    const size_t kstep = (size_t)(BK * 2);
    const size_t hstep = (size_t)HALF * K * 2;
    const size_t tstep = 2 * hstep;
    const unsigned ldsw = (unsigned)wid * 1024u;
    const int aoff = lds_byte(wr * 64 + fr, fq * 8), boff = lds_byte(wc * 32 + fr, fq * 8);
#define PG8_SA(b, h) (((b) * 2 + (h)) * HTB)
#define PG8_SB(b, h) ((4 + (b) * 2 + (h)) * HTB)
#define PG8_STAGE(bufoff, gbase, voff) do { _Pragma("unroll") for (int _i = 0; _i < 2; ++_i) \
        __builtin_amdgcn_global_load_lds((const unsigned*)((const char*)(gbase) + (voff)[_i]), (PG8_LAS unsigned*)(lds + (bufoff) + ldsw + _i * 8192), 16, 0, 0); } while (0)
#define PG8_LDA(dst, b, h) do { _Pragma("unroll") for (int m = 0; m < 4; ++m) _Pragma("unroll") for (int k = 0; k < 2; ++k) dst[m][k] = *(const PG8_LAS bf16x8*)(lds + PG8_SA(b, h) + aoff + m * 2048 + k * 1024); } while (0)
#define PG8_LDB(dst, b, h) do { _Pragma("unroll") for (int n = 0; n < 2; ++n) _Pragma("unroll") for (int k = 0; k < 2; ++k) dst[n][k] = *(const PG8_LAS bf16x8*)(lds + PG8_SB(b, h) + boff + n * 2048 + k * 1024); } while (0)
#define PG8_MMA(ai, bj, At, Bt) do { __builtin_amdgcn_s_setprio(1); _Pragma("unroll") for (int m = 0; m < 4; ++m) _Pragma("unroll") for (int n = 0; n < 2; ++n) _Pragma("unroll") for (int k = 0; k < 2; ++k) \
        acc[ai][bj][m][n] = __builtin_amdgcn_mfma_f32_16x16x32_bf16(Bt[n][k], At[m][k], acc[ai][bj][m][n], 0, 0, 0); __builtin_amdgcn_s_setprio(0); } while (0)
#define PG8_WAIT_V(n) asm volatile("s_waitcnt vmcnt(" #n ")" ::: "memory")
#define PG8_WAIT_L(n) asm volatile("s_waitcnt lgkmcnt(" #n ")" ::: "memory")
#define PG8_BAR __builtin_amdgcn_s_barrier()
#define PG8_SCHED __builtin_amdgcn_sched_barrier(0)
    Unit cur, nxt; int ui = 0;
    if (!S.next(0, cur)) return;
    f32x4 acc[2][2][4][2];
    typename Epi::Pre epre;
#pragma unroll
    for (int a = 0; a < 2; ++a)
#pragma unroll
        for (int b = 0; b < 2; ++b)
#pragma unroll
            for (int m = 0; m < 4; ++m)
#pragma unroll
                for (int n = 0; n < 2; ++n) acc[a][b][m][n] = (f32x4){0.f, 0.f, 0.f, 0.f};
    bf16x8 At[4][2], B0[2][2], B1[2][2];
    const char* cA = (const char*)g.A + (size_t)cur.pm * tstep + (cur.half > 0 ? hstep : (size_t)0); const char* cB = (const char*)g.Bt + (size_t)cur.pn * tstep;
    S.a_ready(cur);
    if constexpr (SP2) {
        PG8_STAGE(PG8_SB(0, 0), cB, voffB); PG8_STAGE(PG8_SB(0, 1), cB + hstep, voffB); PG8_STAGE(PG8_SA(0, 0), cA, voffA); PG8_STAGE(PG8_SA(0, 1), cA + hstep, voffA);
        if (wr == 1) PG8_BAR;
        PG8_WAIT_V(2); PG8_BAR;
        PG8_STAGE(PG8_SB(1, 0), cB + kstep, voffB); PG8_STAGE(PG8_SA(1, 0), cA + kstep, voffA); PG8_STAGE(PG8_SB(1, 1), cB + hstep + kstep, voffB);
        PG8_WAIT_V(6); PG8_BAR;
    } else {
        PG8_STAGE(PG8_SB(0, 0), cB, voffB); PG8_STAGE(PG8_SA(0, 0), cA, voffA); PG8_STAGE(PG8_SB(0, 1), cB + hstep, voffB); PG8_STAGE(PG8_SA(0, 1), cA + hstep, voffA);
        if (wr == 1) PG8_BAR;
        PG8_WAIT_V(4); PG8_BAR;
        PG8_STAGE(PG8_SB(1, 0), cB + kstep, voffB); PG8_STAGE(PG8_SA(1, 0), cA + kstep, voffA); PG8_STAGE(PG8_SB(1, 1), cB + hstep + kstep, voffB);
        PG8_WAIT_V(6); PG8_BAR;
    }
    for (;;) {
        const bool has_next = S.next(ui + 1, nxt);
        const char* nA = has_next ? (const char*)g.A + (size_t)nxt.pm * tstep + (nxt.half > 0 ? hstep : (size_t)0) : cA; const char* nB = has_next ? (const char*)g.Bt + (size_t)nxt.pn * tstep : cB;
        for (int t = 0; t < nt; t += 2) {
            const bool last = (t == nt - 2);
            if (last) E.preload(epre, cur, wr, wc, fr, fq, lds);
            const char* a1 = cA + (size_t)(t + 1) * kstep;
            const char* a2 = last ? nA : cA + (size_t)(t + 2) * kstep; const char* b2 = last ? nB : cB + (size_t)(t + 2) * kstep;
            const char* a3 = a2 + kstep; const char* b3 = b2 + kstep;
            if (last && has_next) S.a_ready(nxt);
            if constexpr (SP2) {
            PG8_LDB(B0, 0, 0); PG8_LDB(B1, 0, 1); PG8_SCHED; PG8_LDA(At, 0, 0); PG8_STAGE(PG8_SA(1, 1), a1 + hstep, voffA);
            PG8_WAIT_V(8); PG8_WAIT_L(0); PG8_BAR; PG8_MMA(0, 0, At, B0); PG8_MMA(0, 1, At, B1); PG8_BAR; PG8_SCHED;
            PG8_LDA(At, 0, 1); PG8_STAGE(PG8_SB(0, 0), b2, voffB); PG8_STAGE(PG8_SB(0, 1), b2 + hstep, voffB); PG8_STAGE(PG8_SA(0, 0), a2, voffA);
            PG8_WAIT_V(8); PG8_WAIT_L(0); PG8_BAR; if (cur.half < 0) { PG8_MMA(1, 0, At, B0); PG8_MMA(1, 1, At, B1); } PG8_BAR; PG8_SCHED;
            PG8_LDB(B0, 1, 0); PG8_LDB(B1, 1, 1); PG8_SCHED; PG8_LDA(At, 1, 0); PG8_STAGE(PG8_SA(0, 1), a2 + hstep, voffA);
            PG8_WAIT_V(8); PG8_WAIT_L(0); PG8_BAR; PG8_MMA(0, 0, At, B0); PG8_MMA(0, 1, At, B1); PG8_BAR; PG8_SCHED;
            PG8_LDA(At, 1, 1); PG8_STAGE(PG8_SB(1, 0), b3, voffB); PG8_STAGE(PG8_SB(1, 1), b3 + hstep, voffB); PG8_STAGE(PG8_SA(1, 0), a3, voffA);
            PG8_WAIT_V(8); PG8_WAIT_L(0); PG8_BAR; if (cur.half < 0) { PG8_MMA(1, 0, At, B0); PG8_MMA(1, 1, At, B1); } PG8_BAR; PG8_SCHED;
            } else {
            PG8_LDB(B0, 0, 0); PG8_SCHED; PG8_LDA(At, 0, 0); PG8_STAGE(PG8_SA(1, 1), a1 + hstep, voffA);
            PG8_WAIT_L(8); PG8_BAR; PG8_WAIT_L(0); PG8_MMA(0, 0, At, B0); PG8_BAR; PG8_SCHED;
            PG8_LDB(B1, 0, 1); PG8_STAGE(PG8_SB(0, 0), b2, voffB);
            PG8_BAR; PG8_WAIT_L(0); PG8_MMA(0, 1, At, B1); PG8_BAR;
            PG8_LDA(At, 0, 1); PG8_STAGE(PG8_SA(0, 0), a2, voffA);
            PG8_BAR; PG8_WAIT_L(0); PG8_MMA(1, 0, At, B0); PG8_BAR; PG8_SCHED;
            PG8_STAGE(PG8_SB(0, 1), b2 + hstep, voffB);
            PG8_WAIT_V(6); PG8_BAR; PG8_MMA(1, 1, At, B1); PG8_BAR;
            PG8_LDB(B0, 1, 0); PG8_SCHED; PG8_LDA(At, 1, 0); PG8_STAGE(PG8_SA(0, 1), a2 + hstep, voffA);
            PG8_WAIT_L(8); PG8_BAR; PG8_WAIT_L(0); PG8_MMA(0, 0, At, B0); PG8_BAR; PG8_SCHED;
            PG8_LDB(B1, 1, 1); PG8_STAGE(PG8_SB(1, 0), b3, voffB);
            PG8_BAR; PG8_WAIT_L(0); PG8_MMA(0, 1, At, B1); PG8_BAR;
            PG8_LDA(At, 1, 1); PG8_STAGE(PG8_SA(1, 0), a3, voffA);
            PG8_BAR; PG8_WAIT_L(0); PG8_MMA(1, 0, At, B0); PG8_BAR; PG8_SCHED;
            PG8_STAGE(PG8_SB(1, 1), b3 + hstep, voffB);
            PG8_WAIT_V(6); PG8_BAR; PG8_MMA(1, 1, At, B1); PG8_BAR;
            }
        }
        if constexpr (ALIGN_EPI) { if (wr == 0) PG8_BAR; }
        if constexpr (!Epi::AFTER_DRAIN) { E(acc, cur, wr, wc, fr, fq, epre, lds); S.done(cur); }
        if (!has_next) break;
#pragma unroll
        for (int a = 0; a < 2; ++a)
#pragma unroll
            for (int b = 0; b < 2; ++b)
#pragma unroll
                for (int m = 0; m < 4; ++m)
#pragma unroll
                    for (int n = 0; n < 2; ++n) acc[a][b][m][n] = (f32x4){0.f, 0.f, 0.f, 0.f};
        cur = nxt; cA = nA; cB = nB; ++ui;
        if constexpr (ALIGN_EPI) { if (wr == 1) PG8_BAR; }
    }
    PG8_WAIT_V(0);
    if constexpr (!ALIGN_EPI) { if (wr == 0) PG8_BAR; }
    PG8_BAR;
    if constexpr (Epi::AFTER_DRAIN) { E.fused(acc, cur, wr, wc, fr, fq, lds, wid, lane); S.done(cur); }
#undef PG8_SA
#undef PG8_SB
#undef PG8_STAGE
#undef PG8_LDA
#undef PG8_LDB
#undef PG8_MMA
#undef PG8_WAIT_V
#undef PG8_WAIT_L
#undef PG8_BAR
#undef PG8_SCHED
}
}

#define LAS __attribute__((address_space(3)))
typedef unsigned short bf16_t;
typedef short bf16x8 __attribute__((ext_vector_type(8)));
typedef float f32x4 __attribute__((ext_vector_type(4)));
typedef float f32x2 __attribute__((ext_vector_type(2)));
typedef float f32x16 __attribute__((ext_vector_type(16)));
typedef unsigned u32x4 __attribute__((ext_vector_type(4)));
typedef unsigned u32x2 __attribute__((ext_vector_type(2)));

constexpr int DM = 1024, NCTX = 8192, MTOK = 40960, DEPTH = 4, INW = 1792, FF = 4096;
constexpr float EPS = 1e-6f, LOG2E = 1.4426950408889634f, QSCALE = 0.125f * 1.4426950408889634f;
constexpr size_t MiB = 1u << 20;
constexpr size_t WS_RSS = 482 * (size_t)(1u << 20);
typedef unsigned long long u64_t;
constexpr float RSS_SCALE = 16777216.f, RSS_INV = 1.f / 16777216.f;
__device__ __forceinline__ u64_t rss_fix(float s) { return (u64_t)(s * RSS_SCALE + 0.5f); }
__device__ __forceinline__ float rss_flt(u64_t v) { return (float)v * RSS_INV; }
constexpr size_t WS_MOD = 3 * MiB, WS_GV1 = 4 * MiB, WS_GV2 = 4 * MiB + 256 * 1024, WS_B1 = 4 * MiB + 512 * 1024, WS_B2 = 5 * MiB;
constexpr size_t WS_ROPE = 6 * MiB, WS_CK = 7 * MiB, WS_CV = 9 * MiB, WS_GMW = 11 * MiB, WS_BAR = 12 * MiB, WS_XCNT = 13 * MiB;
constexpr size_t WS_BT1 = 16 * MiB, WS_BT2 = 30 * MiB, WS_BT3 = 38 * MiB, WS_BT4 = 70 * MiB, WS_XG = 102 * MiB;
constexpr size_t WS_X16 = 182 * MiB;
constexpr size_t WS_PROJ = 262 * MiB, WS_MIX = 402 * MiB, WS_HC = 262 * MiB, WS_HL = 326 * MiB, WS_END = 490 * MiB;
constexpr int LDS_BYTES = 147456;
constexpr int NPHASE = 32;
constexpr int EPI_SCR = 131072 + 1024;

#ifndef SKIP_G1
#define SKIP_G1 0
#endif
#ifndef SKIP_G2
#define SKIP_G2 0
#endif
#ifndef SKIP_G3
#define SKIP_G3 0
#endif
#ifndef SKIP_G4
#define SKIP_G4 0
#endif
#ifndef SKIP_MIX
#define SKIP_MIX 0
#endif
#ifndef SKIP_P0
#define SKIP_P0 0
#endif
#ifndef P0A_REP
#define P0A_REP 1
#endif
#ifndef PROBE_REP
#define PROBE_REP 0
#define PROBE_J 5
#endif
#ifndef PROBE_NOSTORE
#define PROBE_NOSTORE 1
#endif
#ifndef PROBE_ONLY
#define PROBE_ONLY 15
#endif
#ifndef SYNC_REP
#define SYNC_REP 1
#endif
#ifndef MIX_REP
#define MIX_REP 1
#endif
#ifndef MIX_XLO
#define MIX_XLO 0
#define MIX_XHI 2880
#endif
#ifndef G3_REP
#define G3_REP 1
#endif
#ifndef P0_REP
#define P0_REP 1
#endif
#ifndef SKIP_ATT
#define SKIP_ATT 0
#endif
#ifndef SKIP_POOL
#define SKIP_POOL 0
#endif
#ifndef SKIP_CONV
#define SKIP_CONV 0
#endif
#ifndef SKIP_GM
#define SKIP_GM 0
#endif
struct Args { const float* in[25]; float* out; unsigned char* ws; int ph_lo, ph_hi; };
#define AS4 __attribute__((address_space(4)))
__device__ __forceinline__ const AS4 Args* kargs() { const AS4 Args* p = (const AS4 Args*)__builtin_amdgcn_kernarg_segment_ptr(); asm volatile("" : "+s"(p)); return p; }

__device__ __forceinline__ unsigned pkbf(float lo, float hi) { unsigned r; asm("v_cvt_pk_bf16_f32 %0, %1, %2" : "=v"(r) : "v"(lo), "v"(hi)); return r; }
__device__ __forceinline__ float bflo(unsigned w) { return __uint_as_float(w << 16); }
__device__ __forceinline__ float bfhi(unsigned w) { return __uint_as_float(w & 0xffff0000u); }
__device__ __forceinline__ float sigm(float x) { return __builtin_amdgcn_rcpf(1.f + __expf(-x)); }
__device__ __forceinline__ float gelu_t(float x) { return x * sigm(1.5957691216f * (x + 0.044715f * x * x * x)); }
__device__ __forceinline__ int modrow(int row) { return row < NCTX ? 0 : 1 + ((row - NCTX) >> 12); }
__device__ __forceinline__ int in_phys(int n) {
    if (n < 384) { const int j = n & 63; return (n & ~63) + 2 * (j & 31) + (j >> 5); }
    if (n >= 768 && n < 1024) { const int c = n - 768; return 768 + (c >> 7) * 256 + (c & 127); }
    if (n >= 1024 && n < 1280) { const int c = n - 1024; return 768 + (c >> 7) * 256 + 128 + (c & 127); }
    return n; }
template <int CTRL> __device__ __forceinline__ float dppf(float v) { return __builtin_bit_cast(float, __builtin_amdgcn_update_dpp(0, __builtin_bit_cast(int, v), CTRL, 0xf, 0xf, true)); }
__device__ __forceinline__ float wave_sum(float v) {
    v += dppf<0xB1>(v); v += dppf<0x4E>(v); v += dppf<0x141>(v); v += dppf<0x140>(v);
    const int iv = __builtin_bit_cast(int, v);
    return (__builtin_bit_cast(float, __builtin_amdgcn_readlane(iv, 0)) + __builtin_bit_cast(float, __builtin_amdgcn_readlane(iv, 16)))
         + (__builtin_bit_cast(float, __builtin_amdgcn_readlane(iv, 32)) + __builtin_bit_cast(float, __builtin_amdgcn_readlane(iv, 48)));
}
#define LDS_WAIT() asm volatile("s_waitcnt lgkmcnt(0)" ::: "memory")

struct EpiIn {
    static constexpr bool PERM = true, AFTER_DRAIN = false;
    int layer;
    struct Pre { int dummy; };
    __device__ __forceinline__ void preload(Pre&, const pg8::Unit& u, int wr, int wc, int fr, int fq, LAS unsigned char* lds) const {
        asm volatile("" : "+v"(fr), "+v"(fq)); asm volatile("" : "+s"(wr), "+s"(wc));
        const AS4 Args* ka = kargs(); unsigned char* ws = ka->ws;
        const unsigned* rss = (const unsigned*)((const u64_t*)(ws + WS_RSS) + (size_t)layer * MTOK); const float* bias = (const float*)(ws + WS_B1) + (size_t)layer * 9 * INW;
        const int pm = u.pm, pn = u.pn; const int mrow = pm < 32 ? 0 : 1 + ((pm - 32) >> 4);
        const int w = wr * 4 + wc, ln = fq * 16 + fr;
        if (w < 4) {
            __builtin_amdgcn_global_load_lds(rss + 2 * (size_t)(pm * 256 + w * 64 + ln), (LAS unsigned*)(lds + EPI_SCR + w * 256), 4, 0, 0);
            __builtin_amdgcn_global_load_lds(rss + 2 * (size_t)(pm * 256 + w * 64 + ln) + 1, (LAS unsigned*)(lds + EPI_SCR + 2048 + w * 256), 4, 0, 0);
        } else {
            __builtin_amdgcn_global_load_lds((const unsigned*)(bias + mrow * INW + pn * 256 + (w - 4) * 64 + ln), (LAS unsigned*)(lds + EPI_SCR + w * 256), 4, 0, 0);
            __builtin_amdgcn_global_load_lds((const unsigned*)(bias + mrow * INW + pn * 256 + (w - 4) * 64 + ln), (LAS unsigned*)(lds + EPI_SCR + 2048 + w * 256), 4, 0, 0);
        }
    }
    __device__ __forceinline__ void operator()(const f32x4 (&acc)[2][2][4][2], const pg8::Unit& u, int wr, int wc, int fr, int fq, const Pre&, LAS unsigned char* lds) const {
        asm volatile("" : "+v"(fr), "+v"(fq)); asm volatile("" : "+s"(wr), "+s"(wc));
        const LAS float* srs = (const LAS float*)(lds + EPI_SCR); const LAS float* sbi = (const LAS float*)(lds + EPI_SCR + 1024);
        struct { float rsv[2][4]; f32x4 bv[2][2]; } P;
#pragma unroll
        for (int bj = 0; bj < 2; ++bj)
#pragma unroll
            for (int n = 0; n < 2; ++n) P.bv[bj][n] = *(const LAS f32x4*)(sbi + bj * 128 + wc * 32 + 8 * fq + 4 * n);
#pragma unroll
        for (int ai = 0; ai < 2; ++ai)
#pragma unroll
            for (int m = 0; m < 4; ++m) { const int ri = (u.half >= 0 ? u.half : ai) * 128 + wr * 64 + m * 16 + fr; const LAS unsigned* su = (const LAS unsigned*)srs;
                P.rsv[ai][m] = rss_flt(((u64_t)su[512 + ri] << 32) | (u64_t)su[ri]); }
        const AS4 Args* ka = kargs(); unsigned char* ws = ka->ws; float* outp = ka->out;
        bf16_t* proj = (bf16_t*)(ws + WS_PROJ); const float* rss = (const float*)(ws + WS_RSS) + (size_t)layer * MTOK; const float* bias = (const float*)(ws + WS_B1) + (size_t)layer * 9 * INW;
        const float* rope = (const float*)(ws + WS_ROPE); u64_t* gmss = (u64_t*)(ws + WS_RSS) + (size_t)(9 + layer) * MTOK; float* newk = outp + (size_t)MTOK * DM; float* newv = newk + (size_t)32 * DEPTH * 256 * 128;
        const int pm = u.pm, pn = u.pn; const bool ctx = pm < 32; const int mrow = ctx ? 0 : 1 + ((pm - 32) >> 4);
        const int colw = wc * 32 + 8 * fq;
        f32x4 bv[2][2];
#pragma unroll
        for (int bj = 0; bj < 2; ++bj)
#pragma unroll
            for (int n = 0; n < 2; ++n) bv[bj][n] = P.bv[bj][n];
        const int i0 = (wc & 1) * 16 + 4 * fq;
        const bool ropeq = !ctx && pn == 0, ropek = !ctx && pn == 1;
#pragma unroll
        for (int ai = 0; ai < 2; ++ai) {
            if (ai == 1 && u.half >= 0) continue;
            const int rowb = pm * 256 + (u.half >= 0 ? u.half : ai) * 128 + wr * 64 + fr;
            float rsv[4]; f32x4 cs[4][2];
#pragma unroll
            for (int m = 0; m < 4; ++m) rsv[m] = P.rsv[ai][m];
            if (ropeq || ropek) {
#pragma unroll
                for (int m = 0; m < 4; ++m) { const int t = (rowb + m * 16 - NCTX) & 4095; cs[m][0] = *(const f32x4*)(rope + (size_t)(t * 32 + i0) * 2); cs[m][1] = *(const f32x4*)(rope + (size_t)(t * 32 + i0) * 2 + 4); }
            } else {
#pragma unroll
                for (int m = 0; m < 4; ++m) { cs[m][0] = (f32x4){1.f, 0.f, 1.f, 0.f}; cs[m][1] = (f32x4){1.f, 0.f, 1.f, 0.f}; }
            }
            asm volatile("" ::: "memory");
#pragma unroll
            for (int m = 0; m < 4; ++m) {
                const int row = rowb + m * 16;
                const float rs = rsqrtf(rsv[m] * (1.0f / DM) + EPS);
                float ssq = 0.f;
                if (pn == 3 || pn == 4) {
                    const f32x4 a0 = acc[ai][0][m][0] * rs + bv[0][0], a1 = acc[ai][0][m][1] * rs + bv[0][1], g0 = acc[ai][1][m][0] * rs + bv[1][0], g1 = acc[ai][1][m][1] * rs + bv[1][1];
                    u32x4 w; w.x = pkbf(a0[0] * sigm(g0[0]), a0[1] * sigm(g0[1])); w.y = pkbf(a0[2] * sigm(g0[2]), a0[3] * sigm(g0[3]));
                    w.z = pkbf(a1[0] * sigm(g1[0]), a1[1] * sigm(g1[1])); w.w = pkbf(a1[2] * sigm(g1[2]), a1[3] * sigm(g1[3]));
                    *(u32x4*)(proj + (size_t)row * INW + 768 + (pn - 3) * 128 + colw) = w;
                    continue;
                }
#pragma unroll
                for (int bj = 0; bj < 2; ++bj) {
                    f32x4 v0 = acc[ai][bj][m][0] * rs + bv[bj][0], v1 = acc[ai][bj][m][1] * rs + bv[bj][1];
                    const int col = pn * 256 + bj * 128 + colw;
                    const bool isq = (pn == 0), isk = (pn == 1 && bj == 0), isv = (pn == 1 && bj == 1);
                    if (isq || isk) {
                        if (!ctx) {
                            const f32x4 c0 = cs[m][0], c1 = cs[m][1];
                            f32x4 r0, r1;
                            r0[0] = v0[0] * c0[0] - v0[1] * c0[1]; r0[1] = v0[0] * c0[1] + v0[1] * c0[0];
                            r0[2] = v0[2] * c0[2] - v0[3] * c0[3]; r0[3] = v0[2] * c0[3] + v0[3] * c0[2];
                            r1[0] = v1[0] * c1[0] - v1[1] * c1[1]; r1[1] = v1[0] * c1[1] + v1[1] * c1[0];
                            r1[2] = v1[2] * c1[2] - v1[3] * c1[3]; r1[3] = v1[2] * c1[3] + v1[3] * c1[2];
                            v0 = r0; v1 = r1;
                        } else if (isk) {
                            const int b = row >> 8, t = row & 255, kvh = wc >> 1, j0 = (wc & 1) * 32 + 8 * fq;
                            float* o = newk + ((size_t)((b * DEPTH + layer) * 256 + t) * 2 + kvh) * 64 + (j0 >> 1);
                            *(f32x4*)o = (f32x4){v0[0], v0[2], v1[0], v1[2]};
                            *(f32x4*)(o + 32) = (f32x4){v0[1], v0[3], v1[1], v1[3]};
                        }
                        if (isq) { v0 = v0 * QSCALE; v1 = v1 * QSCALE; }
                    } else if (isv) {
                        if (ctx) {
                            const int b = row >> 8, t = row & 255, kvh = wc >> 1, j0 = (wc & 1) * 32 + 8 * fq;
                            float* o = newv + ((size_t)((b * DEPTH + layer) * 256 + t) * 2 + kvh) * 64 + j0;
                            *(f32x4*)o = v0; *(f32x4*)(o + 4) = v1;
                        }
                    } else if (pn >= 5) {
#pragma unroll
                        for (int e = 0; e < 4; ++e) { v0[e] = gelu_t(v0[e]); v1[e] = gelu_t(v1[e]); }
                        if (pn == 6) ssq += (v0[0] * v0[0] + v0[1] * v0[1]) + (v0[2] * v0[2] + v0[3] * v0[3]) + (v1[0] * v1[0] + v1[1] * v1[1]) + (v1[2] * v1[2] + v1[3] * v1[3]);
                    }
                    u32x4 w; w.x = pkbf(v0[0], v0[1]); w.y = pkbf(v0[2], v0[3]); w.z = pkbf(v1[0], v1[1]); w.w = pkbf(v1[2], v1[3]);
                    *(u32x4*)(proj + (size_t)row * INW + col) = w;
                }
                if (pn == 6) { ssq += __shfl_xor(ssq, 16); ssq += __shfl_xor(ssq, 32); if (fq == 0) atomicAdd(gmss + row, rss_fix(ssq)); }
            }
            asm volatile("" ::: "memory");
        }
    }
};

__device__ __forceinline__ bf16_t* hid_base(unsigned char* ws, int hsel) {
    return hsel == 0 ? (bf16_t*)(ws + WS_HC) : (bf16_t*)(ws + WS_HL) - (size_t)(NCTX + (hsel - 1) * 16384) * FF;
}
struct EpiRes {
    static constexpr bool PERM = true, AFTER_DRAIN = false;
    int layer, which;
    struct Pre { int dummy; };
    __device__ __forceinline__ void preload(Pre&, const pg8::Unit&, int, int, int, int, LAS unsigned char*) const {}
    __device__ __forceinline__ void operator()(const f32x4 (&acc)[2][2][4][2], const pg8::Unit& u, int wr, int wc, int fr, int fq, const Pre&, LAS unsigned char*) const {
        asm volatile("" : "+v"(fr), "+v"(fq)); asm volatile("" : "+s"(wr), "+s"(wc));
        const AS4 Args* ka = kargs(); unsigned char* ws = ka->ws;
        const bool first = (layer == 0 && which == 0), last = (layer == DEPTH - 1 && which == 1);
        const float* gate = (const float*)(ws + WS_MOD) + (size_t)layer * 9 * 6144 + (which == 0 ? 2048 : 5120);
        const float* gv = last ? nullptr : (which == 0 ? (const float*)(ws + WS_GV2) + (size_t)layer * 9 * DM : (const float*)(ws + WS_GV1) + (size_t)(layer + 1) * 9 * DM);
        bf16_t* xg = (bf16_t*)(ws + WS_XG); bf16_t* x16 = (bf16_t*)(ws + WS_X16); u64_t* rssn = (u64_t*)(ws + WS_RSS) + (size_t)(which == 0 ? 4 + layer : (last ? 8 : layer + 1)) * MTOK;
        const int pm = u.pm, pn = u.pn; const bool ctx = pm < 32; const int mrow = ctx ? 0 : 1 + ((pm - 32) >> 4);
        const int colw = pn * 256 + wc * 32 + 8 * fq;
        const float* xin = ctx ? ka->in[0] : ka->in[1] - (size_t)NCTX * DM;
        float ssr[2][4];
#pragma unroll
        for (int ai = 0; ai < 2; ++ai)
#pragma unroll
            for (int mq = 0; mq < 4; ++mq) ssr[ai][mq] = 0.f;
        const int nai = u.half >= 0 ? 1 : 2;
        u32x4 pre[4][2];
#define ERES_ROW0(b_) ((size_t)(pm * 256 + (u.half >= 0 ? u.half : ((b_) >> 2)) * 128 + wr * 64 + ((b_) & 1) * 32 + fr) * DM + colw + (((b_) >> 1) & 1) * 128)
#define ERES_LOAD(b_) do { if (!first && (b_) < 4 * nai) { const size_t ob_ = ERES_ROW0(b_); pre[(b_) & 3][0] = *(const u32x4*)(x16 + ob_); pre[(b_) & 3][1] = *(const u32x4*)(x16 + ob_ + (size_t)16 * DM); } } while (0)
        ERES_LOAD(0); ERES_LOAD(1); ERES_LOAD(2);
#pragma unroll
        for (int b = 0; b < 8; ++b) {
            if (b < 4 * nai) {
                const int ai = b >> 2, bj = (b >> 1) & 1, mh = b & 1;
                f32x4 gt[2], gg[2];
#pragma unroll
                for (int n = 0; n < 2; ++n) {
                    gt[n] = *(const f32x4*)(gate + mrow * 6144 + colw + bj * 128 + 4 * n);
                    gg[n] = gv ? *(const f32x4*)(gv + mrow * DM + colw + bj * 128 + 4 * n) : (f32x4){0.f, 0.f, 0.f, 0.f};
                }
                ERES_LOAD(b + 3);
                asm volatile("" ::: "memory");
                const size_t offb = ERES_ROW0(b);
#pragma unroll
                for (int mm = 0; mm < 2; ++mm) {
                    const int mq = mh * 2 + mm;
                    const size_t off = offb + (size_t)mm * 16 * DM;
                    f32x4 b0, b1;
                    if (first) { b0 = *(const f32x4*)(xin + off); b1 = *(const f32x4*)(xin + off + 4); }
                    else { const u32x4 p0 = pre[b & 3][mm]; b0 = (f32x4){bflo(p0.x), bfhi(p0.x), bflo(p0.y), bfhi(p0.y)}; b1 = (f32x4){bflo(p0.z), bfhi(p0.z), bflo(p0.w), bfhi(p0.w)}; }
                    const f32x4 x0 = b0 + gt[0] * acc[ai][bj][mq][0], x1 = b1 + gt[1] * acc[ai][bj][mq][1];
                    u32x4 xw; xw.x = pkbf(x0[0], x0[1]); xw.y = pkbf(x0[2], x0[3]); xw.z = pkbf(x1[0], x1[1]); xw.w = pkbf(x1[2], x1[3]);
                    *(u32x4*)(x16 + off) = xw;
                    ssr[ai][mq] += (x0[0] * x0[0] + x0[1] * x0[1]) + (x0[2] * x0[2] + x0[3] * x0[3]) + (x1[0] * x1[0] + x1[1] * x1[1]) + (x1[2] * x1[2] + x1[3] * x1[3]);
                    if (gv) {
                        const f32x4 y0 = x0 * gg[0], y1 = x1 * gg[1];
                        u32x4 w; w.x = pkbf(y0[0], y0[1]); w.y = pkbf(y0[2], y0[3]); w.z = pkbf(y1[0], y1[1]); w.w = pkbf(y1[2], y1[3]);
                        *(u32x4*)(xg + off) = w;
                    }
                }
                asm volatile("" ::: "memory");
            }
        }
#undef ERES_LOAD
#undef ERES_ROW0
#pragma unroll
        for (int ai = 0; ai < 2; ++ai)
#pragma unroll
            for (int mq = 0; mq < 4; ++mq) {
                if (ai < nai) {
                    const int ah = u.half >= 0 ? u.half : ai;
                    float ss = ssr[ai][mq]; ss += __shfl_xor(ss, 16); ss += __shfl_xor(ss, 32);
                    if (fq == 0) atomicAdd(rssn + pm * 256 + ah * 128 + wr * 64 + mq * 16 + fr, rss_fix(ss));
                }
            }
    }
};

struct EpiUp {
    static constexpr bool PERM = true, AFTER_DRAIN = false;
    int layer; int nostore; int hsel;
    struct Pre { int dummy; };
    __device__ __forceinline__ void preload(Pre&, const pg8::Unit& u, int wr, int wc, int fr, int fq, LAS unsigned char* lds) const {
        asm volatile("" : "+v"(fr), "+v"(fq)); asm volatile("" : "+s"(wr), "+s"(wc));
        const AS4 Args* ka = kargs(); unsigned char* ws = ka->ws;
        const unsigned* rss = (const unsigned*)((const u64_t*)(ws + WS_RSS) + (size_t)(4 + layer) * MTOK); const float* bias = (const float*)(ws + WS_B2) + (size_t)layer * 9 * FF;
        const int pm = u.pm, pn = u.pn; const int mrow = pm < 32 ? 0 : 1 + ((pm - 32) >> 4);
        const int w = wr * 4 + wc, ln = fq * 16 + fr;
        if (w < 4) {
            __builtin_amdgcn_global_load_lds(rss + 2 * (size_t)(pm * 256 + w * 64 + ln), (LAS unsigned*)(lds + EPI_SCR + w * 256), 4, 0, 0);
            __builtin_amdgcn_global_load_lds(rss + 2 * (size_t)(pm * 256 + w * 64 + ln) + 1, (LAS unsigned*)(lds + EPI_SCR + 2048 + w * 256), 4, 0, 0);
        } else {
            __builtin_amdgcn_global_load_lds((const unsigned*)(bias + mrow * FF + pn * 256 + (w - 4) * 64 + ln), (LAS unsigned*)(lds + EPI_SCR + w * 256), 4, 0, 0);
            __builtin_amdgcn_global_load_lds((const unsigned*)(bias + mrow * FF + pn * 256 + (w - 4) * 64 + ln), (LAS unsigned*)(lds + EPI_SCR + 2048 + w * 256), 4, 0, 0);
        }
    }
    __device__ __forceinline__ void operator()(const f32x4 (&acc)[2][2][4][2], const pg8::Unit& u, int wr, int wc, int fr, int fq, const Pre&, LAS unsigned char* lds) const {
        asm volatile("" : "+v"(fr), "+v"(fq)); asm volatile("" : "+s"(wr), "+s"(wc));
        const AS4 Args* ka = kargs(); unsigned char* ws = ka->ws;
        bf16_t* h = hid_base(ws, hsel);
        const int pm = u.pm, pn = u.pn;
        const int colw = pn * 256 + wc * 32 + 8 * fq;
        const LAS float* srs = (const LAS float*)(lds + EPI_SCR); const LAS float* sbi = (const LAS float*)(lds + EPI_SCR + 1024);
        struct { float rsv[2][4]; f32x4 bv[2][2]; } P;
#pragma unroll
        for (int bj = 0; bj < 2; ++bj)
#pragma unroll
            for (int n = 0; n < 2; ++n) P.bv[bj][n] = *(const LAS f32x4*)(sbi + bj * 128 + wc * 32 + 8 * fq + 4 * n);
#pragma unroll
        for (int ai = 0; ai < 2; ++ai)
#pragma unroll
            for (int m = 0; m < 4; ++m) { const int ri = (u.half >= 0 ? u.half : ai) * 128 + wr * 64 + m * 16 + fr; const LAS unsigned* su = (const LAS unsigned*)srs;
                P.rsv[ai][m] = rss_flt(((u64_t)su[512 + ri] << 32) | (u64_t)su[ri]); }
        if (nostore) return;
#pragma unroll
        for (int ai = 0; ai < 2; ++ai)
#pragma unroll
            for (int m = 0; m < 4; ++m) {
                if (ai == 1 && u.half >= 0) continue;
                const int row = pm * 256 + (u.half >= 0 ? u.half : ai) * 128 + wr * 64 + m * 16 + fr;
                const float rs = rsqrtf(P.rsv[ai][m] * (1.0f / DM) + EPS);
#pragma unroll
                for (int bj = 0; bj < 2; ++bj) {
                    f32x4 v0 = acc[ai][bj][m][0] * rs + P.bv[bj][0], v1 = acc[ai][bj][m][1] * rs + P.bv[bj][1];
                    const f32x4 r0 = __builtin_elementwise_max(v0, (f32x4){0.f, 0.f, 0.f, 0.f}), r1 = __builtin_elementwise_max(v1, (f32x4){0.f, 0.f, 0.f, 0.f});
                    v0 = r0 * v0; v1 = r1 * v1;
                    u32x4 w; w.x = pkbf(v0[0], v0[1]); w.y = pkbf(v0[2], v0[3]); w.z = pkbf(v1[0], v1[1]); w.w = pkbf(v1[2], v1[3]);
                    *(u32x4*)(h + (size_t)row * FF + colw + bj * 128) = w;
                }
            }
    }
};

__device__ __forceinline__ void transpose_item(const float* W, int ldw, int k0, int n0, bf16_t* WT, int ldt, bool perm, LAS float* scr, int lane) {
    float tv[32];
#pragma unroll
    for (int i = 0; i < 32; ++i) { const int kk = 2 * i + (lane >> 5); tv[i] = W[(size_t)(k0 + kk) * ldw + n0 + (lane & 31)]; }
#pragma unroll
    for (int i = 0; i < 32; ++i) { const int kk = 2 * i + (lane >> 5); scr[kk * 33 + (lane & 31)] = tv[i]; }
    LDS_WAIT();
    const int c = lane & 7;
#pragma unroll
    for (int j = 0; j < 4; ++j) {
        const int n = (lane >> 3) + 8 * j; const LAS float* s = scr + (8 * c) * 33 + n;
        u32x4 o; o.x = pkbf(s[0 * 33], s[1 * 33]); o.y = pkbf(s[2 * 33], s[3 * 33]); o.z = pkbf(s[4 * 33], s[5 * 33]); o.w = pkbf(s[6 * 33], s[7 * 33]);
        const int nr = perm ? in_phys(n0 + n) : (n0 + n);
        *(u32x4*)(WT + (size_t)nr * ldt + k0 + 8 * c) = o;
    }
    LDS_WAIT();
}

__device__ __forceinline__ void gemv9_block(LAS float* sIn, LAS float* red, const float* W, int ldw, int n0, const float* badd, float* out, int ldo, bool perm, int tid) {
    const int wid = tid >> 6, lane = tid & 63;
    float acc[9];
#pragma unroll
    for (int r = 0; r < 9; ++r) acc[r] = 0.f;
    const float* wp = W + (size_t)(wid * 128) * ldw + n0 + lane;
    float wv[2][32];
#pragma unroll
    for (int i = 0; i < 32; ++i) wv[0][i] = wp[(size_t)i * ldw];
#pragma unroll
    for (int c = 0; c < 4; ++c) {
        if (c + 1 < 4) {
#pragma unroll
            for (int i = 0; i < 32; ++i) wv[(c + 1) & 1][i] = wp[(size_t)((c + 1) * 32 + i) * ldw];
        }
#pragma unroll
        for (int k4 = 0; k4 < 8; ++k4) {
            const float w0 = wv[c & 1][4 * k4], w1 = wv[c & 1][4 * k4 + 1], w2 = wv[c & 1][4 * k4 + 2], w3 = wv[c & 1][4 * k4 + 3];
#pragma unroll
            for (int r = 0; r < 9; ++r) { const f32x4 s = *(const LAS f32x4*)(sIn + r * 1024 + wid * 128 + c * 32 + 4 * k4); acc[r] += (s[0] * w0 + s[1] * w1) + (s[2] * w2 + s[3] * w3); }
        }
    }
#pragma unroll
    for (int r = 0; r < 9; ++r) red[(wid * 9 + r) * 64 + lane] = acc[r];
    __syncthreads();
    for (int idx = tid; idx < 576; idx += 512) {
        const int r = idx >> 6, c = idx & 63; float s = 0.f;
#pragma unroll
        for (int w = 0; w < 8; ++w) s += red[(w * 9 + r) * 64 + c];
        const int nn = n0 + c; if (badd) s += badd[nn];
        out[(size_t)r * ldo + (perm ? in_phys(nn) : nn)] = s;
    }
    __syncthreads();
}


template <int HALF> __device__ __forceinline__ void pool_run(const bf16_t* proj, bf16_t* mix, int s0, int n, int t0, int cv) {
    constexpr int NR = 7 + 2 * HALF;
    u32x4 r[NR];
#pragma unroll
    for (int k = 0; k < NR; ++k) { const int row = t0 - HALF + k; const int rc = min(max(row, 0), n - 1);
        const u32x4 v = *(const u32x4*)(proj + (size_t)(s0 + rc) * INW + 512 + cv * 8); const unsigned msk = (row >= 0 && row < n) ? 0xffffffffu : 0u;
        r[k] = (u32x4){v.x & msk, v.y & msk, v.z & msk, v.w & msk}; }
    float S[8];
#pragma unroll
    for (int e = 0; e < 8; ++e) S[e] = 0.f;
#pragma unroll
    for (int k = 0; k < 2 * HALF; ++k) { S[0] += bflo(r[k].x); S[1] += bfhi(r[k].x); S[2] += bflo(r[k].y); S[3] += bfhi(r[k].y); S[4] += bflo(r[k].z); S[5] += bfhi(r[k].z); S[6] += bflo(r[k].w); S[7] += bfhi(r[k].w); }
#pragma unroll
    for (int e = 0; e < 8; ++e) {
        const int t = t0 + e; const int a = max(t - HALF, 0), b = min(t + HALF, n); const float ic = __builtin_amdgcn_rcpf((float)(b - a));
        const u32x4 c = r[HALF + e];
        u32x4 o; o.x = pkbf(S[0] * ic - bflo(c.x), S[1] * ic - bfhi(c.x)); o.y = pkbf(S[2] * ic - bflo(c.y), S[3] * ic - bfhi(c.y));
        o.z = pkbf(S[4] * ic - bflo(c.z), S[5] * ic - bfhi(c.z)); o.w = pkbf(S[6] * ic - bflo(c.w), S[7] * ic - bfhi(c.w));
        *(u32x4*)(mix + (size_t)(s0 + t) * DM + 256 + cv * 8) = o;
        if (e < 7) { const u32x4 p = r[2 * HALF + e], q = r[e];
            S[0] += bflo(p.x) - bflo(q.x); S[1] += bfhi(p.x) - bfhi(q.x); S[2] += bflo(p.y) - bflo(q.y); S[3] += bfhi(p.y) - bfhi(q.y);
            S[4] += bflo(p.z) - bflo(q.z); S[5] += bfhi(p.z) - bfhi(q.z); S[6] += bflo(p.w) - bflo(q.w); S[7] += bfhi(p.w) - bfhi(q.w); }
    }
}
#define XB_TMO      128
#define XB_XCNT(j)  (256  + 64 * (j))
#define XB_XSUB(j)  (1280 + 64 * (j))
#define XB_XGEN(j)  (2304 + 64 * (j))
#define XB_TOP      3328
#define XB_TOPGEN   3392
#define XCD_BAR_WORDS 3456
#define XB_SPIN_CAP (1u << 18)

__device__ __forceinline__ unsigned xb_ld(unsigned* p)              { return __hip_atomic_load(p, __ATOMIC_RELAXED, __HIP_MEMORY_SCOPE_AGENT); }
__device__ __forceinline__ unsigned xb_add(unsigned* p, unsigned v) { return __hip_atomic_fetch_add(p, v, __ATOMIC_RELAXED, __HIP_MEMORY_SCOPE_AGENT); }
__device__ __forceinline__ unsigned xb_xcc_id() { return (unsigned)__builtin_amdgcn_s_getreg((3 << 11) | 20) & 0xFu; }
#define XB_SPIN(cond, bar) do { unsigned _sp = 0; while (cond) { __builtin_amdgcn_s_sleep(1); \
    if ((++_sp & 255u) == 0u) { if (xb_ld(&(bar)[XB_TMO])) break; if (_sp > XB_SPIN_CAP) { atomicAdd(&(bar)[XB_TMO], 1u); break; } } } } while (0)

struct XcdBarrier {
    unsigned* bar; unsigned x;
    volatile LAS unsigned* st;
};

__device__ __forceinline__ XcdBarrier xcd_barrier_post(unsigned* bar, volatile LAS unsigned* st) {
    XcdBarrier b; b.bar = bar; b.x = xb_xcc_id(); b.st = st;
    if (threadIdx.x == 0) (void)xb_add(&bar[XB_XCNT(b.x)], 1u);
    return b;
}
__device__ __forceinline__ void xcd_barrier_complete(unsigned* bar, unsigned x, unsigned& nloc, unsigned& nx) {
    const unsigned G = gridDim.x * gridDim.y * gridDim.z;
    unsigned sum, cnt, mine, sp = 0u;
    for (;;) {
        sum = 0u; cnt = 0u; mine = 0u;
#pragma unroll
        for (unsigned j = 0; j < 16; ++j) { const unsigned c = xb_ld(&bar[XB_XCNT(j)]); sum += c; cnt += (c > 0u) ? 1u : 0u; mine = (j == x) ? c : mine; }
        if (sum == G) break;
        __builtin_amdgcn_s_sleep(1);
        if ((++sp & 255u) == 0u) { if (xb_ld(&bar[XB_TMO])) break; if (sp > XB_SPIN_CAP) { atomicAdd(&bar[XB_TMO], 1u); break; } }
    }
    nloc = mine > 0u ? mine : 1u; nx = cnt > 0u ? cnt : 1u;
}

__device__ __forceinline__ void xcd_barrier(const XcdBarrier& b) {
    asm volatile("s_waitcnt vmcnt(0)" ::: "memory");
    __syncthreads();
    if (threadIdx.x == 0) {
        unsigned* bar = b.bar;
        __builtin_amdgcn_s_waitcnt(0);
        unsigned nloc = b.st[0], nx = b.st[1];
        if (nloc == 0u) { xcd_barrier_complete(bar, b.x, nloc, nx); b.st[0] = nloc; b.st[1] = nx; }
        const unsigned old = xb_add(&bar[XB_XSUB(b.x)], 1u);
        const unsigned gen = old / nloc;
        if (old + 1u == (gen + 1u) * nloc) {
            __builtin_amdgcn_fence(__ATOMIC_RELEASE, "agent");
            asm volatile("s_waitcnt vmcnt(0)" ::: "memory");
            const unsigned og = xb_add(&bar[XB_TOP], 1u);
            const unsigned tg = og / nx;
            if (og + 1u == (tg + 1u) * nx) xb_add(&bar[XB_TOPGEN], 1u);
            else XB_SPIN(xb_ld(&bar[XB_TOPGEN]) == tg, bar);
            __builtin_amdgcn_fence(__ATOMIC_ACQUIRE, "agent");
            xb_add(&bar[XB_XGEN(b.x)], 1u);
            asm volatile("s_waitcnt vmcnt(0)" ::: "memory");
        } else {
            XB_SPIN(xb_ld(&bar[XB_XGEN(b.x)]) == gen, bar);
            __builtin_amdgcn_fence(__ATOMIC_ACQUIRE, "agent");
            asm volatile("s_waitcnt vmcnt(0)" ::: "memory");
        }
    }
    __syncthreads();
}


__device__ __forceinline__ int census_vcu(const unsigned* cnt, volatile LAS unsigned* cw, int G, int bid) {
    bool ok = (G % 8) == 0;
#pragma unroll
    for (int j = 0; j < 8; ++j) ok = ok && (__hip_atomic_load(cnt + j, __ATOMIC_RELAXED, __HIP_MEMORY_SCOPE_AGENT) == (unsigned)(G / 8));
    const unsigned x = cw[0], r = cw[1];
    return (ok && r < (unsigned)(G / 8)) ? (int)(r * 8u + x) : bid;
}
__device__ __forceinline__ unsigned char* opq(unsigned char* p) { asm volatile("" : "+s"(p)); return p; }
__global__ void __launch_bounds__(512, 2) fwd_kernel(Args args) {
    extern __shared__ __attribute__((aligned(16))) unsigned char lds_raw[];
    LAS unsigned char* lds = (LAS unsigned char*)lds_raw;
    const int tid = threadIdx.x, lane = tid & 63, wid = __builtin_amdgcn_readfirstlane(tid >> 6);
    const int G = gridDim.x, bid = blockIdx.x;
    const int lo = args.ph_lo, hi = args.ph_hi;
#define DECL_PTRS \
    int tid_p = threadIdx.x; asm volatile("" : "+v"(tid_p)); const int tid = tid_p, lane = tid & 63, wid = __builtin_amdgcn_readfirstlane(tid >> 6); (void)lane; (void)wid; \
    const AS4 Args* KA = kargs(); unsigned char* ws = KA->ws; float* out = KA->out; \
    const float* x_prompt = KA->in[0]; const float* x_sample = KA->in[1]; \
    u64_t* rssb = (u64_t*)(ws + WS_RSS); float* modb = (float*)(ws + WS_MOD); \
    float* gv1 = (float*)(ws + WS_GV1); float* gv2 = (float*)(ws + WS_GV2); \
    float* b1 = (float*)(ws + WS_B1); float* b2 = (float*)(ws + WS_B2); float* ropet = (float*)(ws + WS_ROPE); \
    bf16_t* ckb = (bf16_t*)(ws + WS_CK); bf16_t* cvb = (bf16_t*)(ws + WS_CV); bf16_t* gmw = (bf16_t*)(ws + WS_GMW); \
    bf16_t* Bt1 = (bf16_t*)(ws + WS_BT1); bf16_t* Bt2 = (bf16_t*)(ws + WS_BT2); bf16_t* Bt3 = (bf16_t*)(ws + WS_BT3); bf16_t* Bt4 = (bf16_t*)(ws + WS_BT4); \
    bf16_t* xg = (bf16_t*)(ws + WS_XG); bf16_t* proj = (bf16_t*)(ws + WS_PROJ); bf16_t* mix = (bf16_t*)(ws + WS_MIX); bf16_t* x16 = (bf16_t*)(ws + WS_X16); \
    float* newk = out + (size_t)MTOK * DM; float* newv = newk + (size_t)32 * DEPTH * 256 * 128; \
    (void)x_prompt; (void)x_sample; (void)rssb; (void)modb; (void)gv1; (void)gv2; (void)b1; (void)b2; (void)ropet; (void)ckb; (void)cvb; (void)gmw; (void)Bt1; (void)Bt2; (void)Bt3; (void)Bt4; (void)xg; (void)proj; (void)mix; (void)x16; (void)newk; (void)newv
#define IN(k) (lo <= (k) && (k) < hi)
    { volatile LAS unsigned* st0 = (volatile LAS unsigned*)(lds + 131072 + 64); if (tid < 2) st0[tid] = 0u; __syncthreads(); }
    XcdBarrier xbar; xbar.bar = (unsigned*)(kargs()->ws + WS_BAR); xbar.x = 0; xbar.st = (volatile LAS unsigned*)(lds + 131072 + 64);
    { volatile LAS unsigned* cw = (volatile LAS unsigned*)(lds + 131072 + 96);
      if (tid == 0) { const unsigned x = xb_xcc_id() & 7u; cw[0] = x; cw[1] = __hip_atomic_fetch_add((unsigned*)(kargs()->ws + WS_XCNT) + x, 1u, __ATOMIC_RELAXED, __HIP_MEMORY_SCOPE_AGENT); }
      __syncthreads(); }
    int vcu = bid;
    if (lo < hi - 1) xbar = xcd_barrier_post((unsigned*)(kargs()->ws + WS_BAR), (volatile LAS unsigned*)(lds + 131072 + 64));
    if (lo < -1) cg::this_grid().sync();
#define SEAM(k) do { if (IN(k) && IN((k) + 1)) { xcd_barrier(xbar); if ((k) == 0) vcu = census_vcu((const unsigned*)(kargs()->ws + WS_XCNT), (volatile LAS unsigned*)(lds + 131072 + 96), G, bid); } } while (0)

    for (int p0r = 0; p0r < P0A_REP; ++p0r)
    if (IN(0) && !SKIP_P0) {
        DECL_PTRS;
        LAS float* sIn = (LAS float*)lds; LAS float* red = (LAS float*)(lds + 36864);
        for (int i = tid; i < 9 * 1024; i += 512) { const int r = i >> 10, k = i & 1023; const float v = r == 0 ? KA->in[5][k] : KA->in[4][(r - 1) * 1024 + k]; sIn[i] = v / (1.f + expf(-v)); }
        __syncthreads();
        for (int it = bid; it < 4 * 96; it += G) { const int l = it / 96, nb = it % 96;
            gemv9_block(sIn, red, KA->in[6] + (size_t)l * 1024 * 6144, 6144, nb * 64, KA->in[7] + l * 6144, modb + (size_t)l * 9 * 6144, 6144, false, tid); }
        for (int it = bid; it < 512; it += G) {
            const int l = it >> 7, ty = (it >> 6) & 1, nb = (it >> 2) & 15, cb = it & 3; const int n = nb * 64 + lane;
            const float* wo = KA->in[11] + (size_t)l * DM * DM;
            float acc[8];
#pragma unroll
            for (int i = 0; i < 8; ++i) acc[i] = 0.f;
            int kdst;
            if (ty == 0) {
                const float* pw = KA->in[13] + ((size_t)(l * 4 + cb) * 64 + wid * 8) * 64; const float* ps = KA->in[14] + l * 256 + cb * 64;
#pragma unroll 16
                for (int d = 0; d < 64; ++d) { const float wv = wo[(size_t)(256 + cb * 64 + d) * DM + n] * ps[d];
#pragma unroll
                    for (int i = 0; i < 8; ++i) acc[i] += pw[i * 64 + d] * wv; }
                kdst = 256 + cb * 64 + wid * 8;
            } else {
                const float* cp = KA->in[18] + ((size_t)l * 256 + cb * 64 + wid * 8) * 256;
#pragma unroll 16
                for (int d = 0; d < 256; ++d) { const float wv = wo[(size_t)(512 + d) * DM + n];
#pragma unroll
                    for (int i = 0; i < 8; ++i) acc[i] += cp[i * 256 + d] * wv; }
                kdst = 512 + cb * 64 + wid * 8;
            }
            u32x4 o; o.x = pkbf(acc[0], acc[1]); o.y = pkbf(acc[2], acc[3]); o.z = pkbf(acc[4], acc[5]); o.w = pkbf(acc[6], acc[7]);
            *(u32x4*)(Bt2 + (size_t)l * DM * DM + (size_t)n * DM + kdst) = o;
        }
        __syncthreads();
        {
            LAS float* scr = (LAS float*)(lds + wid * 8448);
            const int gw = bid * 8 + wid, NGW = G * 8;
            for (int it = gw; it < 4 * 5248; it += NGW) {
                const int l = it / 5248; int r = it % 5248;
                if (r < 896) { transpose_item(KA->in[10] + (size_t)l * DM * INW, INW, (r / 56) * 64, (r % 56) * 32, Bt1 + (size_t)l * INW * DM, DM, true, scr, lane); continue; } r -= 896;
                if (r < 256) { const int kbi = r >> 5, kb = kbi < 4 ? kbi : kbi + 8; transpose_item(KA->in[11] + (size_t)l * DM * DM, DM, kb * 64, (r & 31) * 32, Bt2 + (size_t)l * DM * DM, DM, false, scr, lane); continue; } r -= 256;
                if (r < 2048) { transpose_item(KA->in[22] + (size_t)l * DM * FF, FF, (r >> 7) * 64, (r & 127) * 32, Bt3 + (size_t)l * FF * DM, DM, false, scr, lane); continue; } r -= 2048;
                transpose_item(KA->in[23] + (size_t)l * FF * DM, DM, (r >> 5) * 64, (r & 31) * 32, Bt4 + (size_t)l * DM * FF, FF, false, scr, lane);
            }
        }
        const int gt = bid * 512 + tid, GT = G * 512;
        for (int i = gt; i < 13 * MTOK; i += GT) rssb[i] = 0ull;
        for (int i = gt; i < 4 * 4 * 128 * 128 / 2; i += GT) { const f32x2 v = *(const f32x2*)(KA->in[20] + 2 * (size_t)i); ((unsigned*)gmw)[i] = pkbf(v[0], v[1]); }
        for (int i = gt; i < 4096 * 32; i += GT) { const int t = i >> 5, p = i & 31; const float pos = (float)(p < 16 ? (t >> 6) : (t & 63));
            const float inv = exp2f(-(float)(p & 15) * (13.287712379549449f / 16.0f)); const float a = pos * inv; ropet[2 * i] = cosf(a); ropet[2 * i + 1] = sinf(a); }
        for (int i = gt; i < 131072; i += GT) {
            const int j0 = (i & 7) * 8; const size_t hb0 = (size_t)(i >> 3) * 64;
            const f32x4 a = *(const f32x4*)(KA->in[2] + hb0 + (j0 >> 1)), b = *(const f32x4*)(KA->in[2] + hb0 + 32 + (j0 >> 1));
            u32x4 o; o.x = pkbf(a[0], b[0]); o.y = pkbf(a[1], b[1]); o.z = pkbf(a[2], b[2]); o.w = pkbf(a[3], b[3]);
            *(u32x4*)(ckb + hb0 + j0) = o;
            const f32x4 c = *(const f32x4*)(KA->in[3] + hb0 + j0), d = *(const f32x4*)(KA->in[3] + hb0 + j0 + 4);
            u32x4 q; q.x = pkbf(c[0], c[1]); q.y = pkbf(c[2], c[3]); q.z = pkbf(d[0], d[1]); q.w = pkbf(d[2], d[3]);
            *(u32x4*)(cvb + hb0 + j0) = q;
        }
    }
    SEAM(0);
    if (IN(1) && !SKIP_P0) {
        DECL_PTRS;
        const int gt = bid * 512 + tid, GT = G * 512;
        for (int i = gt; i < 4 * 9 * 1024; i += GT) { const int l = i / 9216, r = (i % 9216) >> 10, k = i & 1023; const float* mr = modb + (size_t)(l * 9 + r) * 6144;
            gv1[i] = KA->in[8][l * 1024 + k] * (1.f + mr[1024 + k]); gv2[i] = KA->in[9][l * 1024 + k] * (1.f + mr[4096 + k]); }
        LAS float* sIn = (LAS float*)lds; LAS float* red = (LAS float*)(lds + 36864);
        for (int it = bid; it < 368; it += G) {
            int l, nb, off; const float* W; int ldw; float* o; int ldo; bool perm;
            if (it < 112) { l = it / 28; nb = it % 28; off = 0; W = KA->in[10] + (size_t)l * DM * INW; ldw = INW; o = b1 + (size_t)l * 9 * INW; ldo = INW; perm = true; }
            else { const int j = it - 112; l = j >> 6; nb = j & 63; off = 3072; W = KA->in[22] + (size_t)l * DM * FF; ldw = FF; o = b2 + (size_t)l * 9 * FF; ldo = FF; perm = false; }
            for (int i = tid; i < 9 * 1024; i += 512) sIn[i] = modb[(size_t)(l * 9 + (i >> 10)) * 6144 + off + (i & 1023)];
            __syncthreads();
            gemv9_block(sIn, red, W, ldw, nb * 64, nullptr, o, ldo, perm, tid);
        }
        for (int row = bid * 8 + wid; row < MTOK; row += G * 8) {
            const float* src = row < NCTX ? x_prompt + (size_t)row * DM : x_sample + (size_t)(row - NCTX) * DM;
            const float* mr = modb + (size_t)modrow(row) * 6144 + 1024;
            float ss = 0.f;
#pragma unroll
            for (int j = 0; j < 4; ++j) { const int k = 4 * lane + 256 * j; const f32x4 v = *(const f32x4*)(src + k); const f32x4 g = *(const f32x4*)(KA->in[8] + k); const f32x4 s = *(const f32x4*)(mr + k);
                ss += (v[0] * v[0] + v[1] * v[1]) + (v[2] * v[2] + v[3] * v[3]);
                u32x2 w; w.x = pkbf(v[0] * g[0] * (1.f + s[0]), v[1] * g[1] * (1.f + s[1])); w.y = pkbf(v[2] * g[2] * (1.f + s[2]), v[3] * g[3] * (1.f + s[3]));
                *(u32x2*)(xg + (size_t)row * DM + k) = w; }
            ss = wave_sum(ss);
            if (lane == 0) rssb[row] = rss_fix(ss);
        }
    }
    SEAM(1);

#pragma unroll 1
    for (int s = 0; s < 1 + 14 * DEPTH; ++s) {
        int ty, st, ls, ph, grp = 0; bool endslot;
        if (s == 0) { ty = 0; st = 0; ls = 0; ph = 2; endslot = true; }
        else { const int lq = (s - 1) / 14, j = (s - 1) % 14; ph = 3 + 7 * lq + (j >> 1); endslot = (j & 1); ls = lq;
            ty = (j == 0 || j == 13) ? 0 : (j == 1 || j == 2) ? 1 : (j == 3 || j == 4) ? 2 : (j == 5 || j == 7 || j == 10) ? 3 : (j == 6 || j == 8 || j == 12) ? 4 : -1;
            st = (j == 0 || j == 2 || j == 4 || j == 7 || j == 8 || j == 10 || j == 12) ? 1 : 0;
            grp = (j == 10 || j == 12) ? 1 : 0;
            if (j == 13) ls = lq + 1; }
        const bool active = IN(ph) && ls < DEPTH;
#if PROBE_REP
        for (int prep = 0; prep < ((s > 0 && (s - 1) % 14 == PROBE_J) ? 2 : 1); ++prep) {
#endif
        if (active && ty == 0 && !SKIP_G1) {
            DECL_PTRS;
            pg8::Gemm g{xg, Bt1 + (size_t)ls * INW * DM, MTOK, INW, DM}; pg8::StreamOrder S; S.init(st ? 32 : 0, st ? 128 : 32, INW / 256, G, vcu, 0, 0, 0);
            EpiIn E{ls};
            pg8::gemm_phase<EpiIn, pg8::StreamOrder, true, true, DM>(lds, g, S, E);
        }
        if (active && ty == 1 && !SKIP_MIX) {
            DECL_PTRS;
            const int l = ls;
            const int nAtt = st ? 512 : 128, nPool = st ? 256 : 64, nConv = st ? 512 : 128, nGm = st ? 1024 : 256;
            const int oAtt = st ? 0 : 512, oPool = st ? 64 : 0, oConv = st ? 128 : 0, oGm = st ? 256 : 0;
            const int vbid = st ? vcu : (vcu >= (G >> 1) ? vcu - (G >> 1) : (1 << 28)); const int vG = st ? G : (G >> 1);
            for (int itl = vbid; itl < nAtt + nConv; itl += vG) {
                int it;
                if (itl < nAtt) it = oAtt + itl; else it = 960 + oConv + (itl - nAtt);
#if PROBE_REP
                if (prep && !(((it < 640) ? 1 : 2) & PROBE_ONLY)) continue;
#endif
                int tid_o = threadIdx.x; asm volatile("" : "+v"(tid_o)); const int tid = tid_o, lane = tid & 63, wid = __builtin_amdgcn_readfirstlane(tid >> 6);
                if (it < 640) {
#if !SKIP_ATT
                    const bool lat = it < 512; int rowbase, qb, kvh, bidx = 0;
                    if (lat) { bidx = it >> 6; qb = (it & 63) >> 1; kvh = it & 1; rowbase = NCTX + bidx * 4096; }
                    else { const int i = it - 512; rowbase = (i >> 2) * 256; qb = (i >> 1) & 1; kvh = i & 1; }
                    const int jlo = lat ? (qb == 0 ? 1 : 0) : 0, jhi = lat ? (qb == 31 ? 1 : 2) : 1, nloc = jhi - jlo + 1, ntiles = lat ? nloc + 2 : 2;
                    const int hi5 = lane >> 5, l31 = lane & 31;
                    const int g = wid >> 2, tq = (wid & 3) * 32 + l31, h = 2 * kvh + g;
                    const size_t qrow = (size_t)rowbase + qb * 128 + tq;
                    bf16x8 qf[4];
#pragma unroll
                    for (int ds = 0; ds < 4; ++ds) qf[ds] = *(const bf16x8*)(proj + qrow * INW + h * 64 + ds * 16 + hi5 * 8);
                    float mrun = KA->in[12][l * 4 + h] * LOG2E, lrun = hi5 == 0 ? 1.f : 0.f;
                    f32x16 o0, o1;
#pragma unroll
                    for (int r = 0; r < 16; ++r) { o0[r] = 0.f; o1[r] = 0.f; }
                    LAS unsigned char* Ks = lds; LAS unsigned char* Vt = lds + 18432;
                    u32x4 kreg[2], vreg[2];
                    auto tile_src = [&](int ti, const bf16_t*& kp, const bf16_t*& vp, int& pitch, int& mtype) {
                        if (lat && ti >= nloc) { const int c = ti - nloc; kp = ckb + ((size_t)((bidx * 4 + l) * 256 + c * 128) * 2 + kvh) * 64; vp = cvb + ((size_t)((bidx * 4 + l) * 256 + c * 128) * 2 + kvh) * 64; pitch = 128; mtype = 1; }
                        else { const int jb = lat ? jlo + ti : ti; const int kr = lat ? rowbase + (qb - 1 + jb) * 128 : rowbase + ti * 128; kp = proj + (size_t)kr * INW + 256 + kvh * 64; vp = kp + 128; pitch = INW; mtype = lat ? jb : 1; }
                    };
                    { const bf16_t *kp, *vp; int pitch, mt; tile_src(0, kp, vp, pitch, mt);
#pragma unroll
                      for (int i = 0; i < 2; ++i) { const int v = tid + 512 * i, key = v >> 3, cv = v & 7; kreg[i] = *(const u32x4*)(kp + (size_t)key * pitch + cv * 8); vreg[i] = *(const u32x4*)(vp + (size_t)key * pitch + cv * 8); } }
                    for (int ti = 0; ti < ntiles; ++ti) {
                        int mtype; { const bf16_t *kp, *vp; int pitch; tile_src(ti, kp, vp, pitch, mtype); }
                        __syncthreads();
#pragma unroll
                        for (int i = 0; i < 2; ++i) { const int v = tid + 512 * i, key = v >> 3, cv = v & 7;
                            *(LAS u32x4*)(Ks + key * 144 + cv * 16) = kreg[i];
                            LAS unsigned short* vd = (LAS unsigned short*)(Vt + (cv * 8) * 264 + key * 2);
                            vd[0 * 132] = (unsigned short)(vreg[i].x & 0xffff); vd[1 * 132] = (unsigned short)(vreg[i].x >> 16);
                            vd[2 * 132] = (unsigned short)(vreg[i].y & 0xffff); vd[3 * 132] = (unsigned short)(vreg[i].y >> 16);
                            vd[4 * 132] = (unsigned short)(vreg[i].z & 0xffff); vd[5 * 132] = (unsigned short)(vreg[i].z >> 16);
                            vd[6 * 132] = (unsigned short)(vreg[i].w & 0xffff); vd[7 * 132] = (unsigned short)(vreg[i].w >> 16); }
                        __syncthreads();
                        if (ti + 1 < ntiles) { const bf16_t *kp, *vp; int pitch, mt; tile_src(ti + 1, kp, vp, pitch, mt);
#pragma unroll
                            for (int i = 0; i < 2; ++i) { const int v = tid + 512 * i, key = v >> 3, cv = v & 7; kreg[i] = *(const u32x4*)(kp + (size_t)key * pitch + cv * 8); vreg[i] = *(const u32x4*)(vp + (size_t)key * pitch + cv * 8); } }
                        f32x16 p[4];
#pragma unroll
                        for (int kb = 0; kb < 4; ++kb) {
#pragma unroll
                            for (int r = 0; r < 16; ++r) p[kb][r] = 0.f;
#pragma unroll
                            for (int ds = 0; ds < 4; ++ds) { const bf16x8 a = *(const LAS bf16x8*)(Ks + (kb * 32 + l31) * 144 + ds * 32 + hi5 * 16); p[kb] = __builtin_amdgcn_mfma_f32_32x32x16_bf16(a, qf[ds], p[kb], 0, 0, 0); }
                        }
                        if (mtype != 1) {
                            const int dlo = (mtype == 0 ? tq : -1) - 4 * hi5, dhi = (mtype == 0 ? 1000 : tq) - 4 * hi5;
#pragma unroll
                            for (int kb = 0; kb < 4; ++kb)
#pragma unroll
                                for (int r = 0; r < 16; ++r) { const int j = kb * 32 + (r & 3) + 8 * (r >> 2); p[kb][r] = (j >= dlo && j <= dhi) ? p[kb][r] : -1e30f; }
                        }
                        float mx = -1e30f;
#pragma unroll
                        for (int kb = 0; kb < 4; ++kb)
#pragma unroll
                            for (int r = 0; r < 16; ++r) mx = fmaxf(mx, p[kb][r]);
                        mx = fmaxf(mx, __shfl_xor(mx, 32));
                        const float mnew = fmaxf(mrun, mx), alpha = __builtin_amdgcn_exp2f(mrun - mnew); mrun = mnew;
                        float rsum = 0.f;
#pragma unroll
                        for (int kb = 0; kb < 4; ++kb)
#pragma unroll
                            for (int r = 0; r < 16; ++r) { p[kb][r] = __builtin_amdgcn_exp2f(p[kb][r] - mnew); rsum += p[kb][r]; }
                        lrun = lrun * alpha + rsum;
#pragma unroll
                        for (int r = 0; r < 16; ++r) { o0[r] *= alpha; o1[r] *= alpha; }
#pragma unroll
                        for (int kb = 0; kb < 4; ++kb)
#pragma unroll
                            for (int j = 0; j < 2; ++j) {
                                u32x4 pw; pw.x = pkbf(p[kb][8 * j + 0], p[kb][8 * j + 1]); pw.y = pkbf(p[kb][8 * j + 2], p[kb][8 * j + 3]); pw.z = pkbf(p[kb][8 * j + 4], p[kb][8 * j + 5]); pw.w = pkbf(p[kb][8 * j + 6], p[kb][8 * j + 7]);
                                const bf16x8 pf = __builtin_bit_cast(bf16x8, pw);
                                const int kofs = (kb * 32 + 16 * j + 4 * hi5) * 2;
                                { const u32x2 a = *(const LAS u32x2*)(Vt + l31 * 264 + kofs), b = *(const LAS u32x2*)(Vt + l31 * 264 + kofs + 16);
                                  const u32x4 av = (u32x4){a.x, a.y, b.x, b.y}; o0 = __builtin_amdgcn_mfma_f32_32x32x16_bf16(__builtin_bit_cast(bf16x8, av), pf, o0, 0, 0, 0); }
                                { const u32x2 a = *(const LAS u32x2*)(Vt + (32 + l31) * 264 + kofs), b = *(const LAS u32x2*)(Vt + (32 + l31) * 264 + kofs + 16);
                                  const u32x4 av = (u32x4){a.x, a.y, b.x, b.y}; o1 = __builtin_amdgcn_mfma_f32_32x32x16_bf16(__builtin_bit_cast(bf16x8, av), pf, o1, 0, 0, 0); }
                            }
                    }
                    const float lt = lrun + __shfl_xor(lrun, 32), inv = 1.f / lt;
                    bf16_t* op = mix + qrow * DM + h * 64 + 4 * hi5;
#pragma unroll
                    for (int kq = 0; kq < 4; ++kq) {
                        u32x2 w0; w0.x = pkbf(o0[4 * kq] * inv, o0[4 * kq + 1] * inv); w0.y = pkbf(o0[4 * kq + 2] * inv, o0[4 * kq + 3] * inv); *(u32x2*)(op + 8 * kq) = w0;
                        u32x2 w1; w1.x = pkbf(o1[4 * kq] * inv, o1[4 * kq + 1] * inv); w1.y = pkbf(o1[4 * kq + 2] * inv, o1[4 * kq + 3] * inv); *(u32x2*)(op + 32 + 8 * kq) = w1;
                    }
                    __syncthreads();
#endif
                } else if (it < 1600) {
#if !SKIP_CONV
                    const int r0 = (it - 960) * 64; const int s0 = r0 < NCTX ? (r0 & ~255) : NCTX + ((r0 - NCTX) & ~4095); const int n = r0 < NCTX ? 256 : 4096;
                    LAS unsigned* U2 = (LAS unsigned*)lds;
                    LAS float* red = (LAS float*)(lds + 94 * 512);
                    const int c2 = tid & 127, tq4 = tid >> 7;
                    f32x2 wj[31];
#pragma unroll
                    for (int j = 0; j < 31; ++j) wj[j] = *(const f32x2*)(KA->in[15] + (size_t)(l * 31 + j) * 256 + 2 * c2);
                    const f32x2 cb = *(const f32x2*)(KA->in[16] + l * 256 + 2 * c2), gn = *(const f32x2*)(KA->in[17] + l * 256 + 2 * c2);
                    {
                        u32x4 av[6];
#pragma unroll
                        for (int i = 0; i < 6; ++i) { const int v = tid + 512 * i, tr = v >> 5, cv = v & 31, row = r0 + tr - 15; const bool ok = v < 94 * 32 && row >= s0 && row < s0 + n;
                            av[i] = ok ? *(const u32x4*)(proj + (size_t)row * INW + 768 + cv * 8) : (u32x4){0u, 0u, 0u, 0u}; }
#pragma unroll
                        for (int i = 0; i < 6; ++i) { const int v = tid + 512 * i, tr = v >> 5, cv = v & 31; if (v < 94 * 32) *(LAS u32x4*)(U2 + tr * 128 + cv * 4) = av[i]; }
                    }
                    __syncthreads();
                    f32x2 y[16];
#pragma unroll
                    for (int blk = 0; blk < 2; ++blk) {
                        const int t0 = tq4 * 16 + blk * 8;
                        f32x2 uu[38];
#pragma unroll
                        for (int k = 0; k < 38; ++k) { const unsigned w = U2[(t0 + k) * 128 + c2]; uu[k] = (f32x2){bflo(w), bfhi(w)}; }
#pragma unroll
                        for (int e = 0; e < 8; ++e) { f32x2 a = cb;
#pragma unroll
                            for (int j = 0; j < 31; ++j) a = __builtin_elementwise_fma(uu[e + j], wj[j], a);
                            y[blk * 8 + e] = a;
                            const float q = wave_sum(a[0] * a[0] + a[1] * a[1]);
                            if (lane == 0) red[(t0 + e) * 2 + (wid & 1)] = q; }
                    }
                    __syncthreads();
#pragma unroll
                    for (int e = 0; e < 16; ++e) { const int t = tq4 * 16 + e; const f32x2 q = *(const LAS f32x2*)(red + t * 2);
                        const float rs = rsqrtf((q[0] + q[1]) * (1.f / 256.f) + EPS); const float z0 = y[e][0] * rs * gn[0], z1 = y[e][1] * rs * gn[1];
                        *(unsigned*)(mix + (size_t)(r0 + t) * DM + 512 + 2 * c2) = pkbf(z0 * sigm(z0), z1 * sigm(z1)); }
                    __syncthreads();
#endif
                }
            }
            for (int wi = (vbid < (1 << 20) ? vbid * 8 + __builtin_amdgcn_readfirstlane(threadIdx.x >> 6) : (1 << 28)); wi < nPool * 8 + nGm * 2; wi += vG * 8) {
                int tid_o = threadIdx.x; asm volatile("" : "+v"(tid_o)); const int lane = tid_o & 63, wid = __builtin_amdgcn_readfirstlane(tid_o >> 6);
#if PROBE_REP
                if (prep && !(((wi < nPool * 8) ? 4 : 8) & PROBE_ONLY)) continue;
#endif
                if (wi < nPool * 8) {
                    const int pi = oPool + (wi >> 3), w = wi & 7;
                    const int r0 = pi * 128; const int s0 = r0 < NCTX ? (r0 & ~255) : NCTX + ((r0 - NCTX) & ~4095); const int n = r0 < NCTX ? 256 : 4096;
                    const int pg = w & 3, tb = (w >> 2) * 8 + (lane >> 3), cv = pg * 8 + (lane & 7), t0 = (r0 - s0) + tb * 8;
                    if (pg == 0) pool_run<1>(proj, mix, s0, n, t0, cv); else if (pg == 1) pool_run<2>(proj, mix, s0, n, t0, cv);
                    else if (pg == 2) pool_run<4>(proj, mix, s0, n, t0, cv); else pool_run<8>(proj, mix, s0, n, t0, cv);
                } else {
                    const int j = wi - nPool * 8, gi = oGm + (j >> 1), cb = j & 1, ch = gi >> 2, gq = gi & 3, r0 = ch * 128;
                    LAS unsigned char* Vt = lds + wid * 8704;
                    const u64_t* gss = rssb + (size_t)(9 + l) * MTOK;
                    const int hi5 = lane >> 5, l31 = lane & 31, cvq = lane & 3;
                    const int cbase = gq * 64 + cb * 32;
                    const f32x4 n0 = *(const f32x4*)(KA->in[19] + l * 256 + cbase + cvq * 8), n1 = *(const f32x4*)(KA->in[19] + l * 256 + cbase + cvq * 8 + 4);
                    u32x4 wv[8]; float rsq[8];
#pragma unroll
                    for (int i = 0; i < 8; ++i) { const int q = (lane >> 2) + 16 * i; wv[i] = *(const u32x4*)(proj + (size_t)(r0 + q) * INW + 1536 + cbase + cvq * 8); rsq[i] = rss_flt(gss[r0 + q]); }
                    bf16x8 bfr[4][8];
                    float gb[4];
#pragma unroll
                    for (int pbk = 0; pbk < 4; ++pbk) { gb[pbk] = KA->in[21][(l * 4 + gq) * 128 + pbk * 32 + l31];
#pragma unroll
                        for (int s2 = 0; s2 < 8; ++s2) bfr[pbk][s2] = *(const bf16x8*)(gmw + ((size_t)(l * 4 + gq) * 128 + pbk * 32 + l31) * 128 + s2 * 16 + hi5 * 8); }
#pragma unroll
                    for (int i = 0; i < 8; ++i) { const int q = (lane >> 2) + 16 * i; const float rs = rsqrtf(rsq[i] * (1.f / 256.f) + EPS); const u32x4 w = wv[i];
                        LAS unsigned short* vd = (LAS unsigned short*)(Vt + (cvq * 8) * 272 + q * 2);
                        vd[0 * 136] = (unsigned short)(pkbf(bflo(w.x) * rs * n0[0], 0.f) & 0xffff); vd[1 * 136] = (unsigned short)(pkbf(bfhi(w.x) * rs * n0[1], 0.f) & 0xffff);
                        vd[2 * 136] = (unsigned short)(pkbf(bflo(w.y) * rs * n0[2], 0.f) & 0xffff); vd[3 * 136] = (unsigned short)(pkbf(bfhi(w.y) * rs * n0[3], 0.f) & 0xffff);
                        vd[4 * 136] = (unsigned short)(pkbf(bflo(w.z) * rs * n1[0], 0.f) & 0xffff); vd[5 * 136] = (unsigned short)(pkbf(bfhi(w.z) * rs * n1[1], 0.f) & 0xffff);
                        vd[6 * 136] = (unsigned short)(pkbf(bflo(w.w) * rs * n1[2], 0.f) & 0xffff); vd[7 * 136] = (unsigned short)(pkbf(bfhi(w.w) * rs * n1[3], 0.f) & 0xffff); }
                    LDS_WAIT();
                    f32x16 sv[4];
#pragma unroll
                    for (int pbk = 0; pbk < 4; ++pbk)
#pragma unroll
                        for (int r = 0; r < 16; ++r) sv[pbk][r] = 0.f;
#pragma unroll
                    for (int s2 = 0; s2 < 8; ++s2) {
                        const bf16x8 a = *(const LAS bf16x8*)(Vt + l31 * 272 + (s2 * 16 + hi5 * 8) * 2);
#pragma unroll
                        for (int pbk = 0; pbk < 4; ++pbk) sv[pbk] = __builtin_amdgcn_mfma_f32_32x32x16_bf16(a, bfr[pbk][s2], sv[pbk], 0, 0, 0);
                    }
                    LDS_WAIT();
#pragma unroll
                    for (int pbk = 0; pbk < 4; ++pbk) {
                        const size_t prow = (size_t)(r0 + pbk * 32 + l31);
                        u32x2 uu[4];
#pragma unroll
                        for (int kq = 0; kq < 4; ++kq) uu[kq] = *(const u32x2*)(proj + prow * INW + 1280 + cbase + 8 * kq + 4 * hi5);
#pragma unroll
                        for (int kq = 0; kq < 4; ++kq) {
                            u32x2 o; o.x = pkbf(bflo(uu[kq].x) * (sv[pbk][4 * kq] + gb[pbk]), bfhi(uu[kq].x) * (sv[pbk][4 * kq + 1] + gb[pbk]));
                            o.y = pkbf(bflo(uu[kq].y) * (sv[pbk][4 * kq + 2] + gb[pbk]), bfhi(uu[kq].y) * (sv[pbk][4 * kq + 3] + gb[pbk]));
                            *(u32x2*)(mix + prow * DM + 768 + cbase + 8 * kq + 4 * hi5) = o; }
                    }
                }
            }
            __syncthreads();
        }
        if (active && ty == 2 && !SKIP_G2) {
            DECL_PTRS;
            pg8::Gemm g{mix, Bt2 + (size_t)ls * DM * DM, MTOK, DM, DM}; pg8::StreamOrder S; S.init(st ? 32 : 0, st ? 128 : 32, DM / 256, G, vcu, 0, 0, st ? 0 : 1);
            EpiRes E{ls, 0};
            pg8::gemm_phase<EpiRes, pg8::StreamOrder, true, true, DM>(lds, g, S, E);
        }
        if (active && ty == 3 && !SKIP_G3) {
            DECL_PTRS;
            const int hsel = st ? 1 + grp : 0;
            pg8::Gemm g{xg, Bt3 + (size_t)ls * FF * DM, MTOK, FF, DM}; pg8::StreamOrder S;
            S.init(st ? 32 + 64 * grp : 0, st ? 64 : 32, FF / 256, G, vcu, (st && grp == 0) ? 128 : 0, (st && grp == 0) ? 4 : 0, 0);
            EpiUp E{ls, 0, hsel};
            pg8::gemm_phase<EpiUp, pg8::StreamOrder, true, true, DM>(lds, g, S, E);
        }
        if (active && ty == 4 && !SKIP_G4) {
            DECL_PTRS;
            const int hsel = st ? 1 + grp : 0;
            pg8::Gemm g{hid_base(ws, hsel), Bt4 + (size_t)ls * DM * FF, MTOK, DM, FF}; pg8::StreamOrder S; S.init(st ? 32 + 64 * grp : 0, st ? 64 : 32, DM / 256, G, vcu, 0, 0, 0);
            EpiRes E{ls, 1};
            pg8::gemm_phase<EpiRes, pg8::StreamOrder, true, true, FF>(lds, g, S, E);
        }
#if PROBE_REP
        }
#endif
        if (endslot) SEAM(ph);
    }
    if (IN(31)) {
        DECL_PTRS;
        const u64_t* rf = rssb + (size_t)8 * MTOK;
        for (int row = bid * 8 + wid; row < MTOK; row += G * 8) {
            const float rs = rsqrtf(rss_flt(rf[row]) * (1.f / DM) + EPS);
#pragma unroll
            for (int j = 0; j < 2; ++j) { const int k = 8 * lane + 512 * j; const u32x4 w = *(const u32x4*)(x16 + (size_t)row * DM + k);
                const f32x4 g0 = *(const f32x4*)(KA->in[24] + k), g1 = *(const f32x4*)(KA->in[24] + k + 4);
                const f32x4 v0 = (f32x4){bflo(w.x), bfhi(w.x), bflo(w.y), bfhi(w.y)} * rs * g0, v1 = (f32x4){bflo(w.z), bfhi(w.z), bflo(w.w), bfhi(w.w)} * rs * g1;
                *(f32x4*)(out + (size_t)row * DM + k) = v0; *(f32x4*)(out + (size_t)row * DM + k + 4) = v1; }
        }
    }
#undef IN
#undef SEAM
}

#ifndef MK_MULTI
#define MK_MULTI 0
#endif
extern "C" void kernel_launch(void* const* d_in, const int* in_sizes, int n_in, void* d_out, int out_size, void* d_ws, size_t ws_size, hipStream_t stream) {
    static int grid = 0;
    if (grid == 0) {
        if (n_in != 25 || ws_size < WS_END) { fprintf(stderr, "kernel_launch: unexpected n_in %d / ws_size %zu\n", n_in, ws_size); grid = -1; return; }
        int dev = 0, cus = 0, per_cu = 0;
        hipGetDevice(&dev); hipDeviceGetAttribute(&cus, hipDeviceAttributeMultiprocessorCount, dev);
        if (hipFuncSetAttribute((const void*)fwd_kernel, hipFuncAttributeMaxDynamicSharedMemorySize, LDS_BYTES) != hipSuccess) { fprintf(stderr, "kernel_launch: hipFuncSetAttribute failed\n"); grid = -1; return; }
        if (hipOccupancyMaxActiveBlocksPerMultiprocessor(&per_cu, (const void*)fwd_kernel, 512, LDS_BYTES) != hipSuccess || per_cu < 1) per_cu = 1;
        (void)hipGetLastError();
        grid = cus * 1;
    }
    if (grid < 0) return;
    Args a{};
    for (int i = 0; i < 25; ++i) a.in[i] = (const float*)d_in[i];
    a.out = (float*)d_out; a.ws = (unsigned char*)d_ws;
#if MK_MULTI
    for (int p = 0; p < NPHASE; ++p) { a.ph_lo = p; a.ph_hi = p + 1; hipLaunchKernelGGL(fwd_kernel, dim3(grid), dim3(512), LDS_BYTES, stream, a); }
#else
    a.ph_lo = 0; a.ph_hi = NPHASE;
    (void)hipMemsetAsync((char*)d_ws + WS_XCNT, 0, 64, stream);
    (void)hipMemsetAsync((char*)d_ws + WS_BAR, 0, XCD_BAR_WORDS * 4, stream);
    void* kargs[] = {&a};
    hipError_t e = hipLaunchCooperativeKernel((const void*)fwd_kernel, dim3(grid), dim3(512), kargs, LDS_BYTES, stream);
    if (e != hipSuccess) fprintf(stderr, "cooperative launch failed: %s (grid %d)\n", hipGetErrorString(e), grid);
#endif
}
```
